# Optimizing an MI355X kernel written in HIP

```python
import jax, jax.numpy as jnp
from jax import lax
import numpy as np

D_MODEL = 1024
BATCH = 32
SEQ = 2048
DEPTH = 1
DEC_BATCH = 16
DEC_SEQ = 16
PAST_LEN = 4096

CHUNK = 64
D_MIX = D_MODEL
A_WIDTH = D_MIX // 2
B_WIDTH = D_MIX - A_WIDTH
GMLP_CHUNK = 128
A_GROUPS = 4
A_GROUP_DIM = A_WIDTH // A_GROUPS
B_HEADS = 4
B_KEY_DIM = B_WIDTH // B_HEADS
B_VAL_DIM = B_WIDTH // B_HEADS
B_FDIM = B_HEADS * B_KEY_DIM
HGRN_BLOCK = 32
EPS = 1e-6
IN_WIDTH = 3 * A_WIDTH + 2 * B_FDIM + 2 * B_WIDTH

kernel_name = 'hybrid_gmlp_hgrn2_stream_step'


def rmsnorm(x, g):
    xf = x.astype(jnp.float32)
    y = xf * lax.rsqrt(jnp.mean(xf * xf, axis=-1, keepdims=True) + EPS)
    return (y * g).astype(x.dtype)


def layernorm(x, g, b):
    xf = x.astype(jnp.float32)
    mu = jnp.mean(xf, axis=-1, keepdims=True)
    var = jnp.mean(jnp.square(xf - mu), axis=-1, keepdims=True)
    return ((xf - mu) * lax.rsqrt(var + EPS) * g + b).astype(x.dtype)


def hgrn2_chunkwise(q, k, v, log_f, S0, block):
    Bsz, T, H, DK = q.shape
    DV = v.shape[-1]
    N = T // block
    r = lambda t: t.reshape(Bsz, N, block, H, t.shape[-1])
    q, k, v, log_f = r(q), r(k), r(v), r(log_f)
    b = jnp.cumsum(log_f, axis=2)
    b_last = b[:, :, -1]
    q_dec = q * jnp.exp(b)
    k_inv = k * jnp.exp(-b)
    k_end = k * jnp.exp(b_last[:, :, None] - b)
    causal = jnp.tril(jnp.ones((block, block), dtype=bool))
    att = jnp.einsum('bnthd,bnshd->bnhts', q_dec, k_inv)
    att = jnp.where(causal, att, 0.0)
    o_intra = jnp.einsum('bnhts,bnshv->bnthv', att, v)
    dS = jnp.einsum('bnshd,bnshv->nbhdv', k_end, v)
    decay = jnp.moveaxis(jnp.exp(b_last), 1, 0)

    def step(S, inp):
        dec, ds = inp
        return dec[..., None] * S + ds, S

    S_fin, S_start = lax.scan(step, S0, (decay, dS))
    o_inter = jnp.einsum('bnthd,nbhdv->bnthv', q_dec, S_start)
    o = (o_intra + o_inter).reshape(Bsz, T, H, DV)
    return o, S_fin


def mixer_layer(x, c, S0, lb, norm_g, w_ada, b_ada, w_in, ln_v_g, ln_v_b, w_sp, b_sp,
                gnorm_g, w_out):
    Bsz, L, _ = x.shape
    mod = jax.nn.silu(c) @ w_ada + b_ada
    shift, scale, gate = jnp.split(mod, 3, axis=-1)
    h = rmsnorm(x, norm_g) * (1.0 + scale[:, None]) + shift[:, None]
    z = h @ w_in
    o1 = A_WIDTH; o2 = o1 + A_WIDTH; o3 = o2 + A_WIDTH
    o4 = o3 + B_FDIM; o5 = o4 + B_FDIM; o6 = o5 + B_WIDTH
    u, v, ga = z[..., :o1], z[..., o1:o2], z[..., o2:o3]
    qb, fb, ib, gb = z[..., o3:o4], z[..., o4:o5], z[..., o5:o6], z[..., o6:]

    v = layernorm(v, ln_v_g, ln_v_b)
    P = min(L, GMLP_CHUNK)
    N = L // P
    pos = jnp.arange(P)
    mask = (pos[None, :] // CHUNK) <= (pos[:, None] // CHUNK)
    Wm = jnp.where(mask[None], w_sp[:, :P, :P], 0.0)
    vr = v.reshape(Bsz, N, P, A_GROUPS, A_GROUP_DIM)
    sp = jnp.einsum('gij,bnjgc->bnigc', Wm, vr) + jnp.transpose(b_sp[:, :P])[None, None, :, :, None]
    a_out = u * sp.reshape(Bsz, L, A_WIDTH).astype(u.dtype) * jax.nn.silu(ga)

    qf = jax.nn.silu(qb.astype(jnp.float32)).reshape(Bsz, L, B_HEADS, B_KEY_DIM)
    fg = lb + (1.0 - lb) * jax.nn.sigmoid(fb.astype(jnp.float32))
    kf = (1.0 - fg).reshape(Bsz, L, B_HEADS, B_KEY_DIM)
    log_f = jnp.log(fg).reshape(Bsz, L, B_HEADS, B_KEY_DIM)
    vf = ib.astype(jnp.float32).reshape(Bsz, L, B_HEADS, B_VAL_DIM)
    block = HGRN_BLOCK if L % HGRN_BLOCK == 0 else L
    o, S_fin = hgrn2_chunkwise(qf, kf, log_f, vf, S0, block) if False else hgrn2_chunkwise(qf, kf, vf, log_f, S0, block)
    o = rmsnorm(o, gnorm_g.reshape(B_HEADS, B_VAL_DIM)).reshape(Bsz, L, B_WIDTH)
    b_out = o.astype(x.dtype) * jax.nn.silu(gb)

    out = jnp.concatenate([a_out, b_out], axis=-1) @ w_out
    x = x + gate[:, None] * out
    return x, S_fin, v


def setup_inputs(seed: int = 0) -> dict:
    key = jax.random.key(seed)
    ks = jax.random.split(key, 20)
    f32 = jnp.float32
    nrm = lambda k, s: jax.random.normal(k, s, f32)
    return {
        'x_prompt': nrm(ks[0], (BATCH, SEQ, D_MODEL)),
        'x_sample': nrm(ks[1], (DEC_BATCH, DEC_SEQ, D_MODEL)),
        'c_prompt': nrm(ks[2], (BATCH, D_MODEL)),
        'c_sample': nrm(ks[3], (DEC_BATCH, D_MODEL)),
        'state_hgrn': 0.5 * nrm(ks[4], (DEPTH, DEC_BATCH, B_HEADS, B_KEY_DIM, B_VAL_DIM)),
        'norm_g': 1.0 + 0.02 * nrm(ks[5], (DEPTH, D_MODEL)),
        'w_ada': 0.5 * D_MODEL ** -0.5 * nrm(ks[6], (DEPTH, D_MODEL, 3 * D_MODEL)),
        'b_ada': 0.02 * nrm(ks[7], (DEPTH, 3 * D_MODEL)),
        'w_in': D_MODEL ** -0.5 * nrm(ks[8], (DEPTH, D_MODEL, IN_WIDTH)),
        'ln_v_g': 1.0 + 0.02 * nrm(ks[9], (DEPTH, A_WIDTH)),
        'ln_v_b': 0.02 * nrm(ks[10], (DEPTH, A_WIDTH)),
        'w_sp': GMLP_CHUNK ** -0.5 * nrm(ks[11], (DEPTH, A_GROUPS, GMLP_CHUNK, GMLP_CHUNK)),
        'b_sp': 1.0 + 0.1 * nrm(ks[12], (DEPTH, A_GROUPS, GMLP_CHUNK)),
        'lb_logits': 0.1 * nrm(ks[13], (DEPTH + 1, B_FDIM)),
        'gnorm_g': 1.0 + 0.02 * nrm(ks[14], (DEPTH, B_WIDTH)),
        'w_out': D_MIX ** -0.5 * nrm(ks[15], (DEPTH, D_MIX, D_MODEL)),
        'g_final': 1.0 + 0.02 * nrm(ks[16], (D_MODEL,)),
        'w_ada_f': 0.5 * D_MODEL ** -0.5 * nrm(ks[17], (D_MODEL, 2 * D_MODEL)),
        'b_ada_f': 0.02 * nrm(ks[18], (2 * D_MODEL,)),
    }


def final_norm(x, c, g_final, w_ada_f, b_ada_f):
    mod = jax.nn.silu(c) @ w_ada_f + b_ada_f
    shift, scale = jnp.split(mod, 2, axis=-1)
    return rmsnorm(x, g_final) * (1.0 + scale[:, None]) + shift[:, None]


def reference(x_prompt, x_sample, c_prompt, c_sample, state_hgrn, norm_g, w_ada, b_ada,
              w_in, ln_v_g, ln_v_b, w_sp, b_sp, lb_logits, gnorm_g, w_out, g_final,
              w_ada_f, b_ada_f):
    lower = jnp.cumsum(jax.nn.softmax(lb_logits.astype(jnp.float32), axis=0), axis=0)
    xp, xs = x_prompt, x_sample
    Sp_list, Ss_list, vs_list = [], [], []
    for l in range(DEPTH):
        S0p = jnp.zeros((xp.shape[0], B_HEADS, B_KEY_DIM, B_VAL_DIM), jnp.float32)
        xp, Sp, _ = mixer_layer(xp, c_prompt, S0p, lower[l], norm_g[l], w_ada[l], b_ada[l],
                                w_in[l], ln_v_g[l], ln_v_b[l], w_sp[l], b_sp[l],
                                gnorm_g[l], w_out[l])
        xs, Ss, vs = mixer_layer(xs, c_sample, state_hgrn[l].astype(jnp.float32), lower[l],
                                 norm_g[l], w_ada[l], b_ada[l], w_in[l], ln_v_g[l],
                                 ln_v_b[l], w_sp[l], b_sp[l], gnorm_g[l], w_out[l])
        Sp_list.append(Sp)
        Ss_list.append(Ss)
        vs_list.append(vs)
    y_prompt = final_norm(xp, c_prompt, g_final, w_ada_f, b_ada_f)
    y_sample = final_norm(xs, c_sample, g_final, w_ada_f, b_ada_f)
    state_hgrn_prompt = jnp.stack(Sp_list)
    state_hgrn_sample = jnp.stack(Ss_list)
    state_gmlp_v_sample = jnp.stack(vs_list)
    return (y_prompt, y_sample, state_hgrn_prompt, state_hgrn_sample, state_gmlp_v_sample)
```

```cpp
#include <hip/hip_runtime.h>
#include <hip/hip_cooperative_groups.h>
#include <cstdio>
namespace cg = cooperative_groups;

#define LAS __attribute__((address_space(3)))
#define DI __device__ __forceinline__
#define RMAP(r) ((size_t)((((r) >> 4) * bstr) + ((((r) & 7) << 1) | (((r) >> 3) & 1))))
typedef unsigned short bf16_t;
typedef short bf16x8 __attribute__((ext_vector_type(8)));
typedef short s16x4 __attribute__((ext_vector_type(4)));
typedef float f32x4 __attribute__((ext_vector_type(4)));
typedef float f32x2 __attribute__((ext_vector_type(2)));
typedef float f32x16 __attribute__((ext_vector_type(16)));
typedef unsigned u32x4 __attribute__((ext_vector_type(4)));
typedef unsigned u32x2 __attribute__((ext_vector_type(2)));
typedef __bf16 bf2_t __attribute__((ext_vector_type(2)));
typedef _Float16 h2_t __attribute__((ext_vector_type(2)));

constexpr int DM = 1024, SEQ = 2048, MP = 32 * 2048, MS = 256, MT = MP + MS, INW = 3584;
constexpr float EPS = 1e-6f;
constexpr int NTHREADS = 512;

constexpr size_t SZ_ROWS1024_BF = (size_t)MT * 1024 * 2;
constexpr size_t SZ_ROWS512_BF = (size_t)MT * 512 * 2;
constexpr size_t WS_HB = 0;
constexpr size_t WS_WINT = WS_HB + SZ_ROWS1024_BF;
constexpr size_t WS_WOUTT = WS_WINT + (size_t)INW * 1024 * 2;
constexpr size_t WS_MOD = WS_WOUTT + (size_t)1024 * 1024 * 2;
constexpr size_t WS_ROWSS = WS_MOD + (size_t)48 * 5120 * 4;
constexpr size_t WS_WM = WS_ROWSS + (size_t)MT * 4;
constexpr size_t WS_ZB = WS_WM + (size_t)4 * 128 * 128 * 2;
constexpr size_t WS_ZF = WS_ZB + 6 * SZ_ROWS512_BF;
constexpr size_t WS_MIX = WS_ZF + (size_t)MT * 512 * 2;
constexpr size_t WS_XNEW = WS_MIX + SZ_ROWS1024_BF;
constexpr size_t WS_BAR = WS_XNEW + SZ_ROWS1024_BF;
constexpr size_t WS_BAR_BYTES = 16384;
constexpr size_t WS_CTR = WS_BAR + 15360;
constexpr size_t WS_END = WS_BAR + WS_BAR_BYTES;

constexpr int LDS_BYTES = 144 * 1024;

struct Params {
    const float* x_prompt; const float* x_sample; const float* c_prompt; const float* c_sample; const float* state_in;
    const float* norm_g; const float* w_ada; const float* b_ada; const float* w_in; const float* ln_v_g; const float* ln_v_b;
    const float* w_sp; const float* b_sp; const float* lb_logits; const float* gnorm_g; const float* w_out; const float* g_final;
    const float* w_ada_f; const float* b_ada_f;
    float* y_prompt; float* y_sample; float* st_prompt; float* st_sample; float* v_sample;
    bf16_t* hb; bf16_t* winT; bf16_t* woutT; float* mod; float* rowss; bf16_t* wm;
    bf16_t* zu; bf16_t* zv; bf16_t* zga; bf16_t* zq; bf16_t* zi; bf16_t* zgb; unsigned short* zf;
    bf16_t* mix; bf16_t* xnew; unsigned* ctr; unsigned* bar;
    int ph_lo, ph_hi;
};

DI unsigned pk2(float lo, float hi) { f32x2 v = {lo, hi}; bf2_t r = __builtin_convertvector(v, bf2_t); return __builtin_bit_cast(unsigned, r); }
DI unsigned pkh2(float lo, float hi) { f32x2 v = {lo, hi}; h2_t r = __builtin_convertvector(v, h2_t); return __builtin_bit_cast(unsigned, r); }
DI f32x2 unpkh2(unsigned u) { return __builtin_convertvector(__builtin_bit_cast(h2_t, u), f32x2); }
DI float bflo(unsigned u) { return __uint_as_float(u << 16); }
DI float bfhi(unsigned u) { return __uint_as_float(u & 0xffff0000u); }
DI float bf1(bf16_t u) { return __uint_as_float(((unsigned)u) << 16); }
DI float fexp(float x) { return __builtin_amdgcn_exp2f(x * 1.44269504089f); }
DI float frcp(float x) { return __builtin_amdgcn_rcpf(x); }
DI float flog(float x) { return __builtin_amdgcn_logf(x) * 0.69314718056f; }
DI float silu_f(float x) { return x * frcp(1.f + fexp(-x)); }
template <int CTRL> DI float dpp_f(float v) { return __builtin_bit_cast(float, __builtin_amdgcn_update_dpp(0, __builtin_bit_cast(int, v), CTRL, 0xf, 0xf, false)); }
DI float wave_sum(float v) {
    v += dpp_f<0x128>(v); v += dpp_f<0x124>(v); v += dpp_f<0x122>(v); v += dpp_f<0x121>(v);
    const int iv = __builtin_bit_cast(int, v);
    const float r0 = __builtin_bit_cast(float, __builtin_amdgcn_readlane(iv, 0)), r1 = __builtin_bit_cast(float, __builtin_amdgcn_readlane(iv, 16));
    const float r2 = __builtin_bit_cast(float, __builtin_amdgcn_readlane(iv, 32)), r3 = __builtin_bit_cast(float, __builtin_amdgcn_readlane(iv, 48));
    return (r0 + r1) + (r2 + r3);
}
DI f32x16 mfma32(bf16x8 a, bf16x8 b, f32x16 c) { return __builtin_amdgcn_mfma_f32_32x32x16_bf16(a, b, c, 0, 0, 0); }
DI int crow(int reg, int h) { return (reg & 3) + 8 * (reg >> 2) + 4 * h; }


#define XB_TMO      128
#define XB_XCNT(j)  (256  + 64 * (j))
#define XB_XSUB(j)  (1280 + 64 * (j))
#define XB_XGEN(j)  (2304 + 64 * (j))
#define XB_TOP      3328
#define XB_TOPGEN   3392
#define XCD_BAR_WORDS 3456
#define XB_SPIN_CAP (1u << 18)
DI unsigned xb_ld(unsigned* p)              { return __hip_atomic_load(p, __ATOMIC_RELAXED, __HIP_MEMORY_SCOPE_AGENT); }
DI unsigned xb_add(unsigned* p, unsigned v) { return __hip_atomic_fetch_add(p, v, __ATOMIC_RELAXED, __HIP_MEMORY_SCOPE_AGENT); }
DI unsigned xb_xcc_id() { return (unsigned)__builtin_amdgcn_s_getreg((3 << 11) | 20) & 0xFu; }
#define XB_SPIN(cond, bar) do { unsigned _sp = 0; while (cond) { __builtin_amdgcn_s_sleep(1); \
    if ((++_sp & 255u) == 0u) { if (xb_ld(&(bar)[XB_TMO])) break; if (_sp > XB_SPIN_CAP) { atomicAdd(&(bar)[XB_TMO], 1u); break; } } } } while (0)
struct XcdBarrier { unsigned* bar; unsigned x; volatile LAS unsigned* st; };
DI XcdBarrier xcd_barrier_post(unsigned* bar, volatile LAS unsigned* st) {
    XcdBarrier b; b.bar = bar; b.x = xb_xcc_id(); b.st = st;
    if (threadIdx.x == 0) (void)xb_add(&bar[XB_XCNT(b.x)], 1u);
    return b;
}
DI void xcd_barrier_complete(unsigned* bar, unsigned x, unsigned& nloc, unsigned& nx) {
    const unsigned G = gridDim.x * gridDim.y * gridDim.z;
    unsigned sum, cnt, mine, sp = 0u;
    for (;;) {
        sum = 0u; cnt = 0u; mine = 0u;
#pragma unroll
        for (unsigned j = 0; j < 16; ++j) { const unsigned c = xb_ld(&bar[XB_XCNT(j)]); sum += c; cnt += (c > 0u) ? 1u : 0u; mine = (j == x) ? c : mine; }
        if (sum == G) break;
        __builtin_amdgcn_s_sleep(1);
        if ((++sp & 255u) == 0u) { if (xb_ld(&bar[XB_TMO])) break; if (sp > XB_SPIN_CAP) { atomicAdd(&bar[XB_TMO], 1u); break; } }
    }
    nloc = mine > 0u ? mine : 1u; nx = cnt > 0u ? cnt : 1u;
}
DI void xcd_barrier(const XcdBarrier& b) {
    asm volatile("s_waitcnt vmcnt(0)" ::: "memory");
    __syncthreads();
    if (threadIdx.x == 0) {
        unsigned* bar = b.bar;
        __builtin_amdgcn_s_waitcnt(0);
        unsigned nloc = b.st[0], nx = b.st[1];
        if (nloc == 0u) { xcd_barrier_complete(bar, b.x, nloc, nx); b.st[0] = nloc; b.st[1] = nx; }
        const unsigned old = xb_add(&bar[XB_XSUB(b.x)], 1u);
        const unsigned gen = old / nloc;
        if (old + 1u == (gen + 1u) * nloc) {
            __builtin_amdgcn_fence(__ATOMIC_RELEASE, "agent");
            asm volatile("s_waitcnt vmcnt(0)" ::: "memory");
            const unsigned og = xb_add(&bar[XB_TOP], 1u);
            const unsigned tg = og / nx;
            if (og + 1u == (tg + 1u) * nx) xb_add(&bar[XB_TOPGEN], 1u);
            else XB_SPIN(xb_ld(&bar[XB_TOPGEN]) == tg, bar);
            __builtin_amdgcn_fence(__ATOMIC_ACQUIRE, "agent");
            xb_add(&bar[XB_XGEN(b.x)], 1u);
            asm volatile("s_waitcnt vmcnt(0)" ::: "memory");
        } else {
            XB_SPIN(xb_ld(&bar[XB_XGEN(b.x)]) == gen, bar);
            __builtin_amdgcn_fence(__ATOMIC_ACQUIRE, "agent");
            asm volatile("s_waitcnt vmcnt(0)" ::: "memory");
        }
    }
    __syncthreads();
}

namespace pg8 {
constexpr int BM = 256, BK = 64, HALF = 128, HTB = HALF * BK * 2, STAGE_BYTES = 8 * HTB, NXCD = 8, WGM = 8;
DI int lds_byte(int r, int c) { const int st = (r >> 4) * 2 + (c >> 5), rr = r & 15, cc = c & 31, ob = rr * 64 + cc * 2; return st * 1024 + (ob ^ (((ob >> 9) & 1) << 5)); }
DI void stage_rc(int b, int& R, int& C) { const int st = b / 1024, sb = b % 1024, swz = sb ^ (((sb >> 9) & 1) << 5); R = (st >> 1) * 16 + swz / 64; C = (st & 1) * 32 + (swz % 64) / 2; }
DI int perm32(int rho) { const int n = rho >> 4, i = rho & 15; return 8 * (i >> 2) + 4 * n + (i & 3); }
struct Unit { int pm, pn; };
struct Gemm { const bf16_t* A; const bf16_t* Bt; int M, N, K; };
struct StaticOrder {
    int nM, nN, nwg, G, c;
    DI void init(int M, int N, int G_, int c_) { nM = M / BM; nN = N / BM; nwg = nM * nN; G = G_; c = c_; }
    DI bool next(int i, Unit& u) const {
        const long L = (long)i * G + c; if (L >= nwg) return false;
        int wgid = (int)L; { const int q = nwg / NXCD, r = nwg % NXCD, xcd = wgid % NXCD, off = wgid / NXCD; wgid = (xcd < r ? xcd * (q + 1) : r * (q + 1) + (xcd - r) * q) + off; }
        const int nig = WGM * nN, gid = wgid / nig, fm = gid * WGM, gsz = (nM - fm) < WGM ? (nM - fm) : WGM;
        u.pm = fm + ((wgid % nig) % gsz); u.pn = (wgid % nig) / gsz; return true;
    }
};

template <class Epi, class Sched>
DI void gemm_phase(LAS unsigned char* lds, const Gemm g, const Sched& S, const Epi& E) {
    const int tid = threadIdx.x, wid = __builtin_amdgcn_readfirstlane(tid >> 6), lane = tid & 63, wr = wid >> 2, wc = wid & 3, fr = lane & 15, fq = lane >> 4;
    const int K = g.K, nt = K / BK;
    unsigned voffA[2], voffB[2];
#pragma unroll
    for (int i = 0; i < 2; ++i) { int R, C; stage_rc(tid * 16 + i * 8192, R, C); const int Rb = Epi::PERM ? ((R & ~31) + perm32(R & 31)) : R;
        voffA[i] = (unsigned)(R * K + C) * 2u; voffB[i] = (unsigned)(Rb * K + C) * 2u; }
    const size_t kstep = (size_t)(BK * 2);
    const size_t hstep = (size_t)HALF * K * 2;
    const size_t tstep = 2 * hstep;
    const unsigned ldsw = (unsigned)wid * 1024u;
    const int aoff = lds_byte(wr * 64 + fr, fq * 8), boff = lds_byte(wc * 32 + fr, fq * 8);
#define PG8_SA(b, h) (((b) * 2 + (h)) * HTB)
#define PG8_SB(b, h) ((4 + (b) * 2 + (h)) * HTB)
#define PG8_STAGE(bufoff, gbase, voff) do { _Pragma("unroll") for (int _i = 0; _i < 2; ++_i) \
        __builtin_amdgcn_global_load_lds((const unsigned*)((const char*)(gbase) + (voff)[_i]), (LAS unsigned*)(lds + (bufoff) + ldsw + _i * 8192), 16, 0, 0); } while (0)
#define PG8_LDA(dst, b, h) do { _Pragma("unroll") for (int m = 0; m < 4; ++m) _Pragma("unroll") for (int k = 0; k < 2; ++k) dst[m][k] = *(const LAS bf16x8*)(lds + PG8_SA(b, h) + aoff + m * 2048 + k * 1024); } while (0)
#define PG8_LDB(dst, b, h) do { _Pragma("unroll") for (int n = 0; n < 2; ++n) _Pragma("unroll") for (int k = 0; k < 2; ++k) dst[n][k] = *(const LAS bf16x8*)(lds + PG8_SB(b, h) + boff + n * 2048 + k * 1024); } while (0)
#define PG8_MMA(ai, bj, At, Bt) do { __builtin_amdgcn_s_setprio(1); _Pragma("unroll") for (int m = 0; m < 4; ++m) _Pragma("unroll") for (int n = 0; n < 2; ++n) _Pragma("unroll") for (int k = 0; k < 2; ++k) \
        acc[ai][bj][m][n] = __builtin_amdgcn_mfma_f32_16x16x32_bf16(Bt[n][k], At[m][k], acc[ai][bj][m][n], 0, 0, 0); __builtin_amdgcn_s_setprio(0); } while (0)
#define PG8_WAIT_V(n) asm volatile("s_waitcnt vmcnt(" #n ")" ::: "memory")
#define PG8_WAIT_L(n) asm volatile("s_waitcnt lgkmcnt(" #n ")" ::: "memory")
#define PG8_BAR __builtin_amdgcn_s_barrier()
#define PG8_SCHED __builtin_amdgcn_sched_barrier(0)
    Unit cur, nxt; int ui = 0;
    if (!S.next(0, cur)) return;
    f32x4 acc[2][2][4][2];
#pragma unroll
    for (int a = 0; a < 2; ++a)
#pragma unroll
        for (int b = 0; b < 2; ++b)
#pragma unroll
            for (int m = 0; m < 4; ++m)
#pragma unroll
                for (int n = 0; n < 2; ++n) acc[a][b][m][n] = (f32x4){0.f, 0.f, 0.f, 0.f};
    bf16x8 At[4][2], B0[2][2], B1[2][2];
    const char* cA = (const char*)g.A + (size_t)cur.pm * tstep; const char* cB = (const char*)g.Bt + (size_t)cur.pn * tstep;
    PG8_STAGE(PG8_SB(0, 0), cB, voffB); PG8_STAGE(PG8_SA(0, 0), cA, voffA); PG8_STAGE(PG8_SB(0, 1), cB + hstep, voffB); PG8_STAGE(PG8_SA(0, 1), cA + hstep, voffA);
    if (wr == 1) PG8_BAR;
    PG8_WAIT_V(4); PG8_BAR;
    PG8_STAGE(PG8_SB(1, 0), cB + kstep, voffB); PG8_STAGE(PG8_SA(1, 0), cA + kstep, voffA); PG8_STAGE(PG8_SB(1, 1), cB + hstep + kstep, voffB);
    PG8_WAIT_V(6); PG8_BAR;
    for (;;) {
        const bool has_next = S.next(ui + 1, nxt);
        const char* nA = has_next ? (const char*)g.A + (size_t)nxt.pm * tstep : cA; const char* nB = has_next ? (const char*)g.Bt + (size_t)nxt.pn * tstep : cB;
        for (int t = 0; t < nt; t += 2) {
            const bool last = (t == nt - 2);
            const char* a1 = cA + (size_t)(t + 1) * kstep;
            const char* a2 = last ? nA : cA + (size_t)(t + 2) * kstep; const char* b2 = last ? nB : cB + (size_t)(t + 2) * kstep;
            const char* a3 = a2 + kstep; const char* b3 = b2 + kstep;
            PG8_LDB(B0, 0, 0); PG8_SCHED; PG8_LDA(At, 0, 0); PG8_STAGE(PG8_SA(1, 1), a1 + hstep, voffA);
            PG8_WAIT_L(8); PG8_BAR; PG8_WAIT_L(0); PG8_MMA(0, 0, At, B0); PG8_BAR; PG8_SCHED;
            PG8_LDB(B1, 0, 1); PG8_STAGE(PG8_SB(0, 0), b2, voffB);
            PG8_BAR; PG8_WAIT_L(0); PG8_MMA(0, 1, At, B1); PG8_BAR;
            PG8_LDA(At, 0, 1); PG8_STAGE(PG8_SA(0, 0), a2, voffA);
            PG8_BAR; PG8_WAIT_L(0); PG8_MMA(1, 0, At, B0); PG8_BAR; PG8_SCHED;
            PG8_STAGE(PG8_SB(0, 1), b2 + hstep, voffB);
            PG8_WAIT_V(6); PG8_BAR; PG8_MMA(1, 1, At, B1); PG8_BAR;
            PG8_LDB(B0, 1, 0); PG8_SCHED; PG8_LDA(At, 1, 0); PG8_STAGE(PG8_SA(0, 1), a2 + hstep, voffA);
            PG8_WAIT_L(8); PG8_BAR; PG8_WAIT_L(0); PG8_MMA(0, 0, At, B0); PG8_BAR; PG8_SCHED;
            PG8_LDB(B1, 1, 1); PG8_STAGE(PG8_SB(1, 0), b3, voffB);
            PG8_BAR; PG8_WAIT_L(0); PG8_MMA(0, 1, At, B1); PG8_BAR;
            PG8_LDA(At, 1, 1); PG8_STAGE(PG8_SA(1, 0), a3, voffA);
            PG8_BAR; PG8_WAIT_L(0); PG8_MMA(1, 0, At, B0); PG8_BAR; PG8_SCHED;
            PG8_STAGE(PG8_SB(1, 1), b3 + hstep, voffB);
            PG8_WAIT_V(6); PG8_BAR; PG8_MMA(1, 1, At, B1); PG8_BAR;
        }
        E(acc, cur, wr, wc, fr, fq);
        if (!has_next) break;
#pragma unroll
        for (int a = 0; a < 2; ++a)
#pragma unroll
            for (int b = 0; b < 2; ++b)
#pragma unroll
                for (int m = 0; m < 4; ++m)
#pragma unroll
                    for (int n = 0; n < 2; ++n) acc[a][b][m][n] = (f32x4){0.f, 0.f, 0.f, 0.f};
        cur = nxt; cA = nA; cB = nB; ++ui;
    }
    PG8_WAIT_V(0);
    if (wr == 0) PG8_BAR;
    PG8_BAR;
#undef PG8_SA
#undef PG8_SB
#undef PG8_STAGE
#undef PG8_LDA
#undef PG8_LDB
#undef PG8_MMA
#undef PG8_WAIT_V
#undef PG8_WAIT_L
#undef PG8_BAR
#undef PG8_SCHED
}
}

DI size_t hoff(int row, int h) {
    return row < MP ? ((size_t)((row >> 11) * 4 + h) * 2048 + (row & 2047)) * 128
                    : (size_t)MP * 512 + ((size_t)(((row - MP) >> 4) * 4 + h) * 16 + ((row - MP) & 15)) * 128;
}
struct EpiZ {
    static constexpr bool PERM = true;
    bf16_t* zb; unsigned short* zf; const float* lbl;
    DI void operator()(const f32x4 (&acc)[2][2][4][2], const pg8::Unit& u, int wr, int wc, int fr, int fq) const {
        const int row0 = u.pm * 256 + wr * 64 + fr;
        if (u.pn < 4) {
            const int c0 = u.pn * 128 + wc * 32 + 8 * fq;
#pragma unroll
            for (int ai = 0; ai < 2; ++ai)
#pragma unroll
                for (int m = 0; m < 4; ++m) { bf16_t* rowp = zb + (size_t)(row0 + ai * 128 + m * 16) * 512 + c0;
                    f32x4 v0 = acc[ai][0][m][0], v1 = acc[ai][0][m][1]; const f32x4 g0 = acc[ai][1][m][0], g1 = acc[ai][1][m][1];
#pragma unroll
                    for (int j = 0; j < 4; ++j) { v0[j] *= silu_f(g0[j]); v1[j] *= silu_f(g1[j]); }
                    u32x4 w; w.x = pk2(v0[0], v0[1]); w.y = pk2(v0[2], v0[3]); w.z = pk2(v1[0], v1[1]); w.w = pk2(v1[2], v1[3]);
                    *(u32x4*)(rowp) = w; }
            return;
        }
        const int sec = (u.pn >> 1) - 1;
        const int cbase = (u.pn & 1) * 256 + wc * 32 + 8 * fq;
        const bool smp = (u.pm == MP / 256);
        const int hMS = smp ? 4 * 16 * 128 : 16 * 128, hBS = smp ? 16 * 128 : 2048 * 128;
        const size_t hLB = hoff(u.pm * 256 + wr * 64 + fr, (u.pn & 1) * 2) + wc * 32 + 8 * fq;
        if (sec == 3) {
            float lb[2][8];
#pragma unroll
            for (int bj = 0; bj < 2; ++bj)
#pragma unroll
                for (int j = 0; j < 8; ++j) { const int c = cbase + bj * 128 + j; lb[bj][j] = 1.f / (1.f + __expf(lbl[512 + c] - lbl[c])); }
#pragma unroll
            for (int ai = 0; ai < 2; ++ai)
#pragma unroll
                for (int m = 0; m < 4; ++m) {
#pragma unroll
                    for (int bj = 0; bj < 2; ++bj) { float k0[4], k1[4];
                        unsigned short* rowp = zf + hLB + (size_t)((ai * 8 + m) * hMS + bj * hBS) - bj * 128;
#pragma unroll
                        for (int j = 0; j < 4; ++j) {
                            k0[j] = (1.f - lb[bj][j]) * frcp(1.f + fexp(acc[ai][bj][m][0][j])); k1[j] = (1.f - lb[bj][4 + j]) * frcp(1.f + fexp(acc[ai][bj][m][1][j])); }
                        u32x4 w; w.x = pkh2(k0[0], k0[1]); w.y = pkh2(k0[2], k0[3]); w.z = pkh2(k1[0], k1[1]); w.w = pkh2(k1[2], k1[3]);
                        *(u32x4*)(rowp + bj * 128) = w; } }
        } else {
            const bool act = (sec == 2) || (sec == 5);
            bf16_t* base = zb + (size_t)(sec == 1 ? 1 : (sec == 2 ? 3 : (sec == 4 ? 4 : 5))) * ((size_t)MT * 512);
#pragma unroll
            for (int ai = 0; ai < 2; ++ai)
#pragma unroll
                for (int m = 0; m < 4; ++m) { const int row = row0 + ai * 128 + m * 16;
#pragma unroll
                    for (int bj = 0; bj < 2; ++bj) { f32x4 v0 = acc[ai][bj][m][0], v1 = acc[ai][bj][m][1];
                        bf16_t* rowp = (sec == 1 ? base + (size_t)row * 512 + cbase : base + hLB + (size_t)((ai * 8 + m) * hMS + bj * hBS) - bj * 128);
                        if (act) {
#pragma unroll
                            for (int j = 0; j < 4; ++j) { v0[j] = silu_f(v0[j]); v1[j] = silu_f(v1[j]); } }
                        u32x4 w; w.x = pk2(v0[0], v0[1]); w.y = pk2(v0[2], v0[3]); w.z = pk2(v1[0], v1[1]); w.w = pk2(v1[2], v1[3]);
                        *(u32x4*)(rowp + bj * 128) = w; } }
        }
    }
};

struct EpiOut {
    static constexpr bool PERM = true;
    bf16_t* ob;
    DI void operator()(const f32x4 (&acc)[2][2][4][2], const pg8::Unit& u, int wr, int wc, int fr, int fq) const {
        const int row0 = u.pm * 256 + wr * 64 + fr, col0 = u.pn * 256 + wc * 32 + 8 * fq;
#pragma unroll
        for (int ai = 0; ai < 2; ++ai)
#pragma unroll
            for (int m = 0; m < 4; ++m) { bf16_t* rowp = ob + (size_t)(row0 + ai * 128 + m * 16) * 1024 + col0;
#pragma unroll
                for (int bj = 0; bj < 2; ++bj) { const f32x4 v0 = acc[ai][bj][m][0], v1 = acc[ai][bj][m][1];
                    u32x4 w; w.x = pk2(v0[0], v0[1]); w.y = pk2(v0[2], v0[3]); w.z = pk2(v1[0], v1[1]); w.w = pk2(v1[2], v1[3]);
                    *(u32x4*)(rowp + bj * 128) = w; } }
    }
};


DI void sgemm_out_item(const bf16_t* __restrict__ A, const bf16_t* __restrict__ Bt, int rb, int cb, bf16_t* __restrict__ ob, LAS unsigned char* lds) {
    const int tid = threadIdx.x, wave = __builtin_amdgcn_readfirstlane(tid >> 6), lane = tid & 63, l16 = lane & 15, kg = lane >> 4;
    const int mt = wave & 3, kh = wave >> 2;
    const bf16_t* ap = A + (size_t)(rb * 64 + mt * 16 + l16) * 1024 + kh * 512 + kg * 8;
    const bf16_t* bp = Bt + (size_t)(cb * 16 + l16) * 1024 + kh * 512 + kg * 8;
    bf16x8 af[16], bfv[16];
#pragma unroll
    for (int ks = 0; ks < 16; ++ks) { af[ks] = *(const bf16x8*)(ap + ks * 32); bfv[ks] = *(const bf16x8*)(bp + ks * 32); }
    f32x4 acc = {0.f, 0.f, 0.f, 0.f};
#pragma unroll
    for (int ks = 0; ks < 16; ++ks) acc = __builtin_amdgcn_mfma_f32_16x16x32_bf16(bfv[ks], af[ks], acc, 0, 0, 0);
    __syncthreads();
    if (kh == 1) *(LAS f32x4*)(lds + (mt * 64 + lane) * 16) = acc;
    __syncthreads();
    if (kh == 0) { acc += *(const LAS f32x4*)(lds + (mt * 64 + lane) * 16);
        u32x2 w; w.x = pk2(acc[0], acc[1]); w.y = pk2(acc[2], acc[3]);
        *(u32x2*)(ob + ((size_t)MP + rb * 64 + mt * 16 + l16) * 1024 + cb * 16 + 4 * kg) = w; }
}

DI void p0_transpose_tile(const float* __restrict__ W, int ldw, bf16_t* __restrict__ Wt, int k0, int n0, int nsrc, LAS float* tile) {
    const int tid = threadIdx.x;
    { const int nn = tid & 63, kg = tid >> 6;
#pragma unroll
      for (int i = 0; i < 8; ++i) { const int kk = kg * 8 + i; tile[kk * 65 + nn] = W[(size_t)(k0 + kk) * ldw + nsrc + nn]; } }
    __syncthreads();
    { const int kp = tid & 31, ng = tid >> 5;
#pragma unroll
      for (int i = 0; i < 4; ++i) { const int nn = ng * 4 + i; const unsigned w = pk2(tile[(2 * kp) * 65 + nn], tile[(2 * kp + 1) * 65 + nn]);
          *(unsigned*)(Wt + (size_t)(n0 + nn) * 1024 + k0 + 2 * kp) = w; } }
    __syncthreads();
}

DI void p0_mod_item(int it, const Params& P, LAS float* sm) {
    const int tid = threadIdx.x, cg = tid & 7, rg = (tid >> 3) & 3, kq = tid >> 5;
    const int j0 = it * 32; const float* W; int ldw; const float* bias; int jc;
    if (j0 < 3072) { W = P.w_ada; ldw = 3072; bias = P.b_ada; jc = j0; } else { W = P.w_ada_f; ldw = 2048; bias = P.b_ada_f; jc = j0 - 3072; }
    f32x4 acc[12];
#pragma unroll
    for (int r = 0; r < 12; ++r) acc[r] = (f32x4){0.f, 0.f, 0.f, 0.f};
#pragma unroll 1
    for (int pass = 0; pass < 2; ++pass) {
        const float* Wp = W + (size_t)(pass * 512 + kq * 32) * ldw + jc + cg * 4;
        f32x4 wc[8];
#pragma unroll
        for (int kk = 0; kk < 8; ++kk) wc[kk] = *(const f32x4*)(Wp + (size_t)kk * ldw);
        __syncthreads();
        for (int e = tid; e < 48 * 512; e += NTHREADS) { const int r = e >> 9, kk = e & 511;
            const float x = (r < 32) ? P.c_prompt[r * 1024 + pass * 512 + kk] : P.c_sample[(r - 32) * 1024 + pass * 512 + kk];
            sm[kk * 52 + r] = silu_f(x); }
        __syncthreads();
#pragma unroll 1
        for (int bt = 0; bt < 4; ++bt) {
            f32x4 wn[8];
            const int nb = (bt + 1 < 4) ? bt + 1 : 3;
#pragma unroll
            for (int kk = 0; kk < 8; ++kk) wn[kk] = *(const f32x4*)(Wp + (size_t)(nb * 8 + kk) * ldw);
#pragma unroll
            for (int kk = 0; kk < 8; ++kk) { const int k = kq * 32 + bt * 8 + kk; const f32x4 w = wc[kk];
#pragma unroll
                for (int r4 = 0; r4 < 3; ++r4) { const f32x4 sv = *(const LAS f32x4*)(sm + k * 52 + rg * 12 + r4 * 4);
                    acc[r4 * 4 + 0] += w * sv[0]; acc[r4 * 4 + 1] += w * sv[1]; acc[r4 * 4 + 2] += w * sv[2]; acc[r4 * 4 + 3] += w * sv[3]; } }
#pragma unroll
            for (int kk = 0; kk < 8; ++kk) wc[kk] = wn[kk];
        }
    }
    __syncthreads();
#pragma unroll
    for (int r = 0; r < 12; ++r) *(LAS f32x4*)(sm + (kq * 48 + rg * 12 + r) * 32 + cg * 4) = acc[r];
    __syncthreads();
    for (int e = tid; e < 48 * 32; e += NTHREADS) { const int r = e >> 5, cc = e & 31; float sacc = bias[jc + cc];
#pragma unroll
        for (int q = 0; q < 16; ++q) sacc += sm[(q * 48 + r) * 32 + cc];
        P.mod[r * 5120 + j0 + cc] = sacc; }
    __syncthreads();
}

DI void phase0(const Params& P, LAS unsigned char* lds) {
    const int tid = threadIdx.x, G = gridDim.x, bid = blockIdx.x;
    LAS float* sm = (LAS float*)lds;
    for (int e = bid * NTHREADS + tid; e < 4 * 128 * 128; e += G * NTHREADS) { const int i = (e >> 7) & 127, j = e & 127;
        const float w = ((j >> 6) <= (i >> 6)) ? P.w_sp[e] : 0.f; P.wm[e] = (bf16_t)(pk2(w, 0.f) & 0xffffu); }
    constexpr int N_MOD = 160, N_TIN = 16 * 56, N_TOUT = 16 * 16;
    for (int it = bid; it < N_MOD; it += G) p0_mod_item(it, P, sm);
    LAS unsigned* qw = (LAS unsigned*)(lds + 140 * 1024);
    for (;;) {
        __syncthreads();
        if (tid == 0) *qw = atomicAdd(P.ctr + 2, 2u);
        __syncthreads();
        const int q0 = (int)*qw;
        if (q0 >= N_TIN + N_TOUT) break;
#pragma unroll 1
        for (int q = q0; q < q0 + 2 && q < N_TIN + N_TOUT; ++q) {
            if (q < N_TIN) { const int n0 = (q >> 4) * 64;
                const int src = (n0 < 1024) ? (((n0 & 255) < 128) ? (n0 >> 8) * 128 + (n0 & 127) : 1024 + (n0 >> 8) * 128 + (n0 & 127)) : (n0 < 1536 ? n0 - 512 : n0);
                p0_transpose_tile(P.w_in, INW, P.winT, (q & 15) * 64, n0, src, sm); }
            else { const int q2 = q - N_TIN; p0_transpose_tile(P.w_out, 1024, P.woutT, (q2 & 15) * 64, (q2 >> 4) * 64, (q2 >> 4) * 64, sm); }
        }
    }
}

DI void p1_rows(const float* __restrict__ xrows, bf16_t* __restrict__ hrows, int nrows, int bstr, const float* modb, const float* norm_g, LAS float* sm) {
    const int tid = threadIdx.x, wave = tid >> 6, lane = tid & 63;
    __syncthreads();
    for (int k = tid; k < 1024; k += NTHREADS) { sm[k] = norm_g[k] * (1.f + modb[1024 + k]); sm[1024 + k] = modb[k]; }
    __syncthreads();
    f32x4 cA[4], cB[4];
#pragma unroll
    for (int q = 0; q < 4; ++q) { const int o = q * 256 + lane * 4; cA[q] = *(const LAS f32x4*)(sm + o); cB[q] = *(const LAS f32x4*)(sm + 1024 + o); }
    f32x4 a[2][4];
#pragma unroll
    for (int u = 0; u < 2; ++u) { const float* xr = xrows + RMAP(wave + 8 * u) * 1024 + lane * 4;
#pragma unroll
        for (int q = 0; q < 4; ++q) a[u][q] = *(const f32x4*)(xr + q * 256); }
    for (int r = wave; r < nrows; r += 16) {
        f32x4 nx[2][4];
        const int rn = (r + 16 < nrows) ? r + 16 : r;
#pragma unroll
        for (int u = 0; u < 2; ++u) { const float* xr = xrows + RMAP(rn + 8 * u) * 1024 + lane * 4;
#pragma unroll
            for (int q = 0; q < 4; ++q) nx[u][q] = *(const f32x4*)(xr + q * 256); }
#pragma unroll
        for (int u = 0; u < 2; ++u) {
            float ss = 0.f;
#pragma unroll
            for (int q = 0; q < 4; ++q)
#pragma unroll
                for (int j = 0; j < 4; ++j) ss += a[u][q][j] * a[u][q][j];
            ss = wave_sum(ss);
            const float rstd = rsqrtf(ss * (1.f / 1024.f) + EPS);
            bf16_t* hr = hrows + RMAP(r + 8 * u) * 1024 + lane * 4;
#pragma unroll
            for (int q = 0; q < 4; ++q) { const f32x4 h = a[u][q] * rstd * cA[q] + cB[q]; u32x2 w; w.x = pk2(h[0], h[1]); w.y = pk2(h[2], h[3]); *(u32x2*)(hr + q * 256) = w; }
        }
#pragma unroll
        for (int u = 0; u < 2; ++u)
#pragma unroll
            for (int q = 0; q < 4; ++q) a[u][q] = nx[u][q];
    }
}

DI void p5_rows(const float* __restrict__ xrows, const bf16_t* __restrict__ orows, float* __restrict__ yrows, int nrows, int bstr, const float* modb, const float* g_final, LAS float* sm) {
    const int tid = threadIdx.x, wave = tid >> 6, lane = tid & 63;
    __syncthreads();
    for (int k = tid; k < 1024; k += NTHREADS) { sm[k] = g_final[k] * (1.f + modb[3072 + 1024 + k]); sm[1024 + k] = modb[3072 + k]; sm[2048 + k] = modb[2048 + k]; }
    __syncthreads();
    f32x4 cA[4], cB[4], cG[4];
#pragma unroll
    for (int q = 0; q < 4; ++q) { const int o = q * 256 + lane * 4; cA[q] = *(const LAS f32x4*)(sm + o); cB[q] = *(const LAS f32x4*)(sm + 1024 + o); cG[q] = *(const LAS f32x4*)(sm + 2048 + o); }
    f32x4 a[2][4]; u32x2 w[2][4];
#pragma unroll
    for (int u = 0; u < 2; ++u) { const float* xr = xrows + RMAP(wave + 8 * u) * 1024 + lane * 4; const bf16_t* orow = orows + RMAP(wave + 8 * u) * 1024 + lane * 4;
#pragma unroll
        for (int q = 0; q < 4; ++q) { a[u][q] = *(const f32x4*)(xr + q * 256); w[u][q] = *(const u32x2*)(orow + q * 256); } }
    for (int r = wave; r < nrows; r += 16) {
        f32x4 nx[2][4]; u32x2 nw[2][4];
        const int rn = (r + 16 < nrows) ? r + 16 : r;
#pragma unroll
        for (int u = 0; u < 2; ++u) { const float* xr = xrows + RMAP(rn + 8 * u) * 1024 + lane * 4; const bf16_t* orow = orows + RMAP(rn + 8 * u) * 1024 + lane * 4;
#pragma unroll
            for (int q = 0; q < 4; ++q) { nx[u][q] = *(const f32x4*)(xr + q * 256); nw[u][q] = *(const u32x2*)(orow + q * 256); } }
#pragma unroll
        for (int u = 0; u < 2; ++u) {
            float ss = 0.f; f32x4 xn[4];
#pragma unroll
            for (int q = 0; q < 4; ++q) { const f32x4 o = {bflo(w[u][q].x), bfhi(w[u][q].x), bflo(w[u][q].y), bfhi(w[u][q].y)};
                xn[q] = a[u][q] + cG[q] * o;
#pragma unroll
                for (int j = 0; j < 4; ++j) ss += xn[q][j] * xn[q][j]; }
            ss = wave_sum(ss);
            const float rstd = rsqrtf(ss * (1.f / 1024.f) + EPS);
            float* yr = yrows + RMAP(r + 8 * u) * 1024 + lane * 4;
#pragma unroll
            for (int q = 0; q < 4; ++q) *(f32x4*)(yr + q * 256) = xn[q] * rstd * cA[q] + cB[q];
        }
#pragma unroll
        for (int u = 0; u < 2; ++u)
#pragma unroll
            for (int q = 0; q < 4; ++q) { a[u][q] = nx[u][q]; w[u][q] = nw[u][q]; }
    }
}

constexpr int GM_VN_PITCH = 272;
constexpr int GM_SP_PITCH = 1040;
DI void gmlp_item(int b, int n, const Params& P, LAS unsigned char* lds) {
    const int tid = threadIdx.x, wave = __builtin_amdgcn_readfirstlane(tid >> 6), lane = tid & 63, r = lane & 31, hh = lane >> 5;
    const size_t row0 = (size_t)b * SEQ + (size_t)n * 128;
    const int g = wave >> 1, ih = wave & 1;
    const bf16_t* wm = P.wm + g * 16384;
    bf16x8 bfr[8][2];
    u32x4 raw[16];
#pragma unroll
    for (int jj = 0; jj < 16; ++jj) raw[jj] = *(const u32x4*)(P.zv + (row0 + wave * 16 + jj) * 512 + lane * 8);
    const f32x4 g0 = *(const f32x4*)(P.ln_v_g + lane * 8), g1 = *(const f32x4*)(P.ln_v_g + lane * 8 + 4), b0 = *(const f32x4*)(P.ln_v_b + lane * 8), b1 = *(const f32x4*)(P.ln_v_b + lane * 8 + 4);
    const float gg[8] = {g0[0], g0[1], g0[2], g0[3], g1[0], g1[1], g1[2], g1[3]}, bb[8] = {b0[0], b0[1], b0[2], b0[3], b1[0], b1[1], b1[2], b1[3]};
    __syncthreads();
#pragma unroll
    for (int half = 0; half < 2; ++half) {
        float vals[8][8];
#pragma unroll
        for (int jj = 0; jj < 8; ++jj) { const u32x4 w = raw[half * 8 + jj];
            const float xs[8] = {bflo(w.x), bfhi(w.x), bflo(w.y), bfhi(w.y), bflo(w.z), bfhi(w.z), bflo(w.w), bfhi(w.w)};
            float s1 = 0.f, s2 = 0.f;
#pragma unroll
            for (int cc = 0; cc < 8; ++cc) { s1 += xs[cc]; s2 += xs[cc] * xs[cc]; }
            s1 = wave_sum(s1); s2 = wave_sum(s2);
            const float mean = s1 * (1.f / 512.f), var = fmaxf(s2 * (1.f / 512.f) - mean * mean, 0.f), rstd = rsqrtf(var + EPS);
#pragma unroll
            for (int cc = 0; cc < 8; ++cc) vals[jj][cc] = (xs[cc] - mean) * rstd * gg[cc] + bb[cc]; }
        const int chunk = (wave * 2 + half) ^ (lane & 15);
#pragma unroll
        for (int cc = 0; cc < 8; ++cc) { u32x4 pkd; pkd.x = pk2(vals[0][cc], vals[1][cc]); pkd.y = pk2(vals[2][cc], vals[3][cc]); pkd.z = pk2(vals[4][cc], vals[5][cc]); pkd.w = pk2(vals[6][cc], vals[7][cc]);
            *(LAS u32x4*)(lds + (lane * 8 + cc) * GM_VN_PITCH + chunk * 16) = pkd; }
    }
#pragma unroll
    for (int ks = 0; ks < 4; ++ks)
#pragma unroll
        for (int it = 0; it < 2; ++it) bfr[ks][it] = *(const bf16x8*)(wm + (ih * 64 + it * 32 + r) * 128 + 16 * ks + 8 * hh);
    __syncthreads();
    f32x16 acc[4][2];
#pragma unroll
    for (int ct = 0; ct < 4; ++ct)
#pragma unroll
        for (int it = 0; it < 2; ++it)
#pragma unroll
            for (int i = 0; i < 16; ++i) acc[ct][it][i] = 0.f;
#pragma unroll
    for (int ks = 0; ks < 8; ++ks) {
        if (ks + 4 < 8) {
#pragma unroll
            for (int it = 0; it < 2; ++it) bfr[ks + 4][it] = *(const bf16x8*)(wm + (ih * 64 + it * 32 + r) * 128 + 16 * (ks + 4) + 8 * hh); }
#pragma unroll
        for (int ct = 0; ct < 4; ++ct) { const int chunk = (2 * ks + hh) ^ ((ct * 4 + (r >> 3)) & 15);
            const bf16x8 a = *(const LAS bf16x8*)(lds + (g * 128 + ct * 32 + r) * GM_VN_PITCH + chunk * 16);
#pragma unroll
            for (int it = 0; it < 2; ++it) acc[ct][it] = mfma32(a, bfr[ks][it], acc[ct][it]); }
    }
    __builtin_amdgcn_sched_barrier(0);
    u32x4 ugv[16];
#pragma unroll
    for (int k = 0; k < 4; ++k) ugv[k] = *(const u32x4*)(P.zu + (row0 + k * 8 + wave) * 512 + lane * 8);
    __syncthreads();
#pragma unroll
    for (int it = 0; it < 2; ++it) { const int i = ih * 64 + it * 32 + r; const float bs = P.b_sp[g * 128 + i];
#pragma unroll
        for (int ct = 0; ct < 4; ++ct)
#pragma unroll
            for (int q = 0; q < 4; ++q) { const int c = g * 128 + ct * 32 + 8 * q + 4 * hh;
                u32x2 w; w.x = pk2(acc[ct][it][4 * q + 0] + bs, acc[ct][it][4 * q + 1] + bs); w.y = pk2(acc[ct][it][4 * q + 2] + bs, acc[ct][it][4 * q + 3] + bs);
                *(LAS u32x2*)(lds + i * GM_SP_PITCH + c * 2) = w; } }
    __syncthreads();
#pragma unroll
    for (int k = 4; k < 16; ++k) ugv[k] = *(const u32x4*)(P.zu + (row0 + k * 8 + wave) * 512 + lane * 8);
#pragma unroll
    for (int k = 0; k < 16; ++k) { const int i = k * 8 + wave; const size_t row = row0 + i;
        const u32x4 uu = ugv[k];
        const u32x4 sp = *(const LAS u32x4*)(lds + i * GM_SP_PITCH + lane * 16);
        u32x4 w;
        w.x = pk2(bflo(uu.x) * bflo(sp.x), bfhi(uu.x) * bfhi(sp.x));
        w.y = pk2(bflo(uu.y) * bflo(sp.y), bfhi(uu.y) * bfhi(sp.y));
        w.z = pk2(bflo(uu.z) * bflo(sp.z), bfhi(uu.z) * bfhi(sp.z));
        w.w = pk2(bflo(uu.w) * bflo(sp.w), bfhi(uu.w) * bfhi(sp.w));
        *(u32x4*)(P.mix + row * 1024 + lane * 8) = w; }
}

DI void gmlp_sample(int b, const Params& P, LAS unsigned char* lds) {
    int tid = threadIdx.x;
    asm volatile("" : "+v"(tid));
    const int wave = __builtin_amdgcn_readfirstlane(tid >> 6), lane = tid & 63;
    LAS float* vn = (LAS float*)lds;
    __syncthreads();
    for (int jj = 0; jj < 2; ++jj) { const int j = wave * 2 + jj; const size_t row = (size_t)MP + b * 16 + j;
        const u32x4 w = *(const u32x4*)(P.zv + row * 512 + lane * 8);
        const float xs[8] = {bflo(w.x), bfhi(w.x), bflo(w.y), bfhi(w.y), bflo(w.z), bfhi(w.z), bflo(w.w), bfhi(w.w)};
        float s1 = 0.f, s2 = 0.f;
#pragma unroll
        for (int cc = 0; cc < 8; ++cc) { s1 += xs[cc]; s2 += xs[cc] * xs[cc]; }
        s1 = wave_sum(s1); s2 = wave_sum(s2);
        const float mean = s1 * (1.f / 512.f), var = fmaxf(s2 * (1.f / 512.f) - mean * mean, 0.f), rstd = rsqrtf(var + EPS);
        float o[8];
#pragma unroll
        for (int cc = 0; cc < 8; ++cc) { o[cc] = (xs[cc] - mean) * rstd * P.ln_v_g[lane * 8 + cc] + P.ln_v_b[lane * 8 + cc]; vn[j * 512 + lane * 8 + cc] = o[cc]; }
        float* vo = P.v_sample + ((size_t)b * 16 + j) * 512 + lane * 8;
        *(f32x4*)(vo) = (f32x4){o[0], o[1], o[2], o[3]}; *(f32x4*)(vo + 4) = (f32x4){o[4], o[5], o[6], o[7]}; }
    __syncthreads();
    { const int c = tid, g = c >> 7;
      float vcol[16];
#pragma unroll
      for (int j = 0; j < 16; ++j) vcol[j] = vn[j * 512 + c];
      for (int i = 0; i < 16; ++i) { float s = P.b_sp[g * 128 + i];
#pragma unroll
          for (int j = 0; j < 16; ++j) s += P.w_sp[(g * 128 + i) * 128 + j] * vcol[j];
          const size_t row = (size_t)MP + b * 16 + i;
          const float o = bf1(P.zu[row * 512 + c]) * s;
          P.mix[row * 1024 + c] = (bf16_t)(pk2(o, 0.f) & 0xffffu); } }
}

constexpr int HG_QD = 0, HG_KI = 8704, HG_KE = 17408, HG_VT = 27648, HG_DEC = 37888, HG_OB = 38400, HG_SS = 55296, HG_STRIDE = 55808;
constexpr int HG_GN = 2 * HG_STRIDE;
DI bf16x8 pack8(const f32x16& x, int s) {
    u32x4 p; p.x = pk2(x[8 * s + 0], x[8 * s + 1]); p.y = pk2(x[8 * s + 2], x[8 * s + 3]); p.z = pk2(x[8 * s + 4], x[8 * s + 5]); p.w = pk2(x[8 * s + 6], x[8 * s + 7]);
    return __builtin_bit_cast(bf16x8, p);
}
DI f32x2 quad_bcast(f32x2 v, int j) {
    f32x2 r;
    if (j == 0) { r.x = dpp_f<0x00>(v.x); r.y = dpp_f<0x00>(v.y); }
    else if (j == 1) { r.x = dpp_f<0x55>(v.x); r.y = dpp_f<0x55>(v.y); }
    else if (j == 2) { r.x = dpp_f<0xAA>(v.x); r.y = dpp_f<0xAA>(v.y); }
    else { r.x = dpp_f<0xFF>(v.x); r.y = dpp_f<0xFF>(v.y); }
    return r;
}
struct HgCtx { size_t rowbase, hbase; int hc, wave, lane, r, hh, rsw, pq, pd0, pv2, ptq, ft, fv0; };
#define HG_BARRIER() do { asm volatile("s_waitcnt lgkmcnt(0)" ::: "memory"); __builtin_amdgcn_s_barrier(); asm volatile("" ::: "memory"); } while (0)
DI void hg_prep_iter(const int it, const HgCtx& C, const Params& P, LAS unsigned char* lds,
                unsigned (&Lfg)[8], unsigned (&Lq)[8], unsigned (&Lw)[8], u32x4& Lg0, u32x4& Lg1,
                const unsigned (&Ufg)[8], const unsigned (&Uq)[8], const unsigned (&Uw)[8], const u32x4& Ug0, const u32x4& Ug1) {
    const int hc = C.hc;
    {
        { const int nb = (it + 2 < 64) ? it + 2 : 63;
          const size_t t0 = C.hbase + (size_t)nb * 32 * 128;
          const unsigned short* zfp = P.zf + t0 + C.pq * 8 * 128 + C.pd0;
          const bf16_t* zqp = P.zq + t0 + C.pq * 8 * 128 + C.pd0;
#pragma unroll
          for (int t = 0; t < 8; ++t) { Lfg[t] = *(const unsigned*)(zfp + t * 128); Lq[t] = *(const unsigned*)(zqp + t * 128); }
          const unsigned* zip = (const unsigned*)(P.zi + t0 + C.ptq * 8 * 128) + C.pv2;
#pragma unroll
          for (int i = 0; i < 8; ++i) Lw[i] = zip[i * 64];
          const int gbk = (it < 64) ? it : 63;
          const bf16_t* gp = P.zgb + C.hbase + ((size_t)gbk * 32 + C.ft) * 128 + C.fv0;
          Lg0 = *(const u32x4*)(gp); Lg1 = *(const u32x4*)(gp + 8); }
        if (it < 64) {
            LAS unsigned char* B = lds + (it & 1) * HG_STRIDE;
            { f32x2 kv[8];
#pragma unroll
              for (int t = 0; t < 8; ++t) kv[t] = unpkh2(Ufg[t]);
              f32x2 pown = (f32x2){1.f, 1.f} - kv[0];
#pragma unroll
              for (int t = 1; t < 8; ++t) pown *= ((f32x2){1.f, 1.f} - kv[t]);
              const f32x2 p0 = quad_bcast(pown, 0), p1 = quad_bcast(pown, 1), p2 = quad_bcast(pown, 2), p3 = quad_bcast(pown, 3);
              const f32x2 c01 = p0 * p1, c012 = c01 * p2, dec = c012 * p3;
              f32x2 eb = (C.pq == 0) ? (f32x2){1.f, 1.f} : (C.pq == 1) ? p0 : (C.pq == 2) ? c01 : c012;
              f32x2 ie; ie.x = frcp(eb.x); ie.y = frcp(eb.y);
              float kex[8], key[8];
#pragma unroll
              for (int tt = 0; tt < 8; ++tt) {
                  const f32x2 k = kv[tt], fg = (f32x2){1.f, 1.f} - k;
                  f32x2 rf; rf.x = frcp(fg.x); rf.y = frcp(fg.y);
                  eb *= fg; ie *= rf;
                  const f32x2 qf = {bflo(Uq[tt]), bfhi(Uq[tt])};
                  const f32x2 qd = qf * eb, ki = k * ie, ke = ki * dec;
                  const int t = C.pq * 8 + tt;
                  const int off = t * 272 + ((C.pd0 * 2) ^ (C.pq << 5));
                  *(LAS unsigned*)(B + HG_QD + off) = pk2(qd.x, qd.y);
                  *(LAS unsigned*)(B + HG_KI + off) = pk2(ki.x, ki.y);
                  kex[tt] = ke.x; key[tt] = ke.y;
              }
              *(LAS u32x4*)(B + HG_KE + C.pd0 * 80 + C.pq * 16) = (u32x4){pk2(kex[0], kex[1]), pk2(kex[2], kex[3]), pk2(kex[4], kex[5]), pk2(kex[6], kex[7])};
              *(LAS u32x4*)(B + HG_KE + (C.pd0 + 1) * 80 + C.pq * 16) = (u32x4){pk2(key[0], key[1]), pk2(key[2], key[3]), pk2(key[4], key[5]), pk2(key[6], key[7])};
              if (C.pq == 0) *(LAS f32x2*)(B + HG_DEC + C.pd0 * 4) = dec; }
            { u32x4 lo, hi;
              lo.x = (Uw[0] & 0xffffu) | (Uw[1] << 16); lo.y = (Uw[2] & 0xffffu) | (Uw[3] << 16); lo.z = (Uw[4] & 0xffffu) | (Uw[5] << 16); lo.w = (Uw[6] & 0xffffu) | (Uw[7] << 16);
              hi.x = (Uw[0] >> 16) | (Uw[1] & 0xffff0000u); hi.y = (Uw[2] >> 16) | (Uw[3] & 0xffff0000u); hi.z = (Uw[4] >> 16) | (Uw[5] & 0xffff0000u); hi.w = (Uw[6] >> 16) | (Uw[7] & 0xffff0000u);
              *(LAS u32x4*)(B + HG_VT + (2 * C.pv2) * 80 + C.ptq * 16) = lo;
              *(LAS u32x4*)(B + HG_VT + (2 * C.pv2 + 1) * 80 + C.ptq * 16) = hi; }
        }
        if (it >= 2) {
            LAS unsigned char* B = lds + (it & 1) * HG_STRIDE;
            const int ft = C.ft, fv0 = C.fv0;
            const size_t row = C.rowbase + (size_t)(it - 2) * 32 + ft;
            LAS float* SSp = (LAS float*)(B + HG_SS);
            const float ss = SSp[ft] + SSp[32 + ft] + SSp[64 + ft] + SSp[96 + ft];
            const float rstd = rsqrtf(ss * (1.f / 128.f) + EPS);
            const float sg[16] = {bflo(Ug0.x), bfhi(Ug0.x), bflo(Ug0.y), bfhi(Ug0.y), bflo(Ug0.z), bfhi(Ug0.z), bflo(Ug0.w), bfhi(Ug0.w),
                                  bflo(Ug1.x), bfhi(Ug1.x), bflo(Ug1.y), bfhi(Ug1.y), bflo(Ug1.z), bfhi(Ug1.z), bflo(Ug1.w), bfhi(Ug1.w)};
            float o[16];
#pragma unroll
            for (int q4 = 0; q4 < 4; ++q4) { const f32x4 ov = *(const LAS f32x4*)(B + HG_OB + ft * 528 + (fv0 + q4 * 4) * 4); const f32x4 gn = *(const LAS f32x4*)(lds + HG_GN + (fv0 + q4 * 4) * 4);
#pragma unroll
                for (int j = 0; j < 4; ++j) o[q4 * 4 + j] = ov[j] * rstd * gn[j] * sg[q4 * 4 + j]; }
            u32x4 w0, w1; w0.x = pk2(o[0], o[1]); w0.y = pk2(o[2], o[3]); w0.z = pk2(o[4], o[5]); w0.w = pk2(o[6], o[7]);
            w1.x = pk2(o[8], o[9]); w1.y = pk2(o[10], o[11]); w1.z = pk2(o[12], o[13]); w1.w = pk2(o[14], o[15]);
            bf16_t* mp = P.mix + row * 1024 + 512 + hc + fv0;
            *(u32x4*)(mp) = w0; *(u32x4*)(mp + 8) = w1;
        }
    }
    HG_BARRIER();
}
DI void hg_state_iter(const int it, const HgCtx& C, LAS unsigned char* lds, f32x16 (&S)[4]) {
    const int r = C.r, hh = C.hh;
    if (it >= 1 && it <= 64) {
        LAS unsigned char* B = lds + ((it - 1) & 1) * HG_STRIDE;
        const int sl = C.wave, rsw = C.rsw;
        bf16x8 fk[8], fq[8];
#pragma unroll
        for (int ks = 0; ks < 8; ++ks) { const int co = ((16 * ks + 8 * hh) * 2) ^ rsw;
            fk[ks] = *(const LAS bf16x8*)(B + HG_KI + r * 272 + co); fq[ks] = *(const LAS bf16x8*)(B + HG_QD + r * 272 + co); }
        s16x4 vlo[2], vhi[2], qlo[4][2], qhi[4][2];
#pragma unroll
        for (int st = 0; st < 2; ++st) { vlo[st] = *(const LAS s16x4*)(B + HG_VT + (sl * 32 + r) * 80 + 2 * (16 * st + 4 * hh)); vhi[st] = *(const LAS s16x4*)(B + HG_VT + (sl * 32 + r) * 80 + 2 * (16 * st + 4 * hh) + 16); }
#pragma unroll
        for (int dt = 0; dt < 4; ++dt)
#pragma unroll
            for (int st = 0; st < 2; ++st) { const int co = (2 * (32 * dt + 16 * st + 4 * hh)) ^ rsw;
                qlo[dt][st] = *(const LAS s16x4*)(B + HG_QD + r * 272 + co); qhi[dt][st] = *(const LAS s16x4*)(B + HG_QD + r * 272 + (co ^ 16)); }
        __builtin_amdgcn_sched_barrier(0);
        f32x16 at;
#pragma unroll
        for (int i = 0; i < 16; ++i) at[i] = 0.f;
#pragma unroll
        for (int ks = 0; ks < 8; ++ks) at = mfma32(fk[ks], fq[ks], at);
        bf16x8 fe[4][2], fv[2]; f32x4 dc[4][4];
#pragma unroll
        for (int st = 0; st < 2; ++st) fv[st] = *(const LAS bf16x8*)(B + HG_VT + (sl * 32 + r) * 80 + 2 * (16 * st + 8 * hh));
#pragma unroll
        for (int dt = 0; dt < 4; ++dt) {
#pragma unroll
            for (int st = 0; st < 2; ++st) fe[dt][st] = *(const LAS bf16x8*)(B + HG_KE + (32 * dt + r) * 80 + 2 * (16 * st + 8 * hh));
#pragma unroll
            for (int q = 0; q < 4; ++q) dc[dt][q] = *(const LAS f32x4*)(B + HG_DEC + (32 * dt + 8 * q + 4 * hh) * 4); }
        __builtin_amdgcn_sched_barrier(0);
#pragma unroll
        for (int i = 0; i < 16; ++i) if (crow(i, hh) > r) at[i] = 0.f;
        f32x16 o;
#pragma unroll
        for (int i = 0; i < 16; ++i) o[i] = 0.f;
#pragma unroll
        for (int st = 0; st < 2; ++st) { const bf16x8 xs = pack8(at, st);
            const bf16x8 a = __builtin_shufflevector(vlo[st], vhi[st], 0, 1, 2, 3, 4, 5, 6, 7);
            o = mfma32(a, xs, o); }
#pragma unroll
        for (int dt = 0; dt < 4; ++dt)
#pragma unroll
            for (int st = 0; st < 2; ++st) { const bf16x8 xs = pack8(S[dt], st);
                const bf16x8 pb = __builtin_shufflevector(qlo[dt][st], qhi[dt][st], 0, 1, 2, 3, 4, 5, 6, 7);
                o = mfma32(xs, pb, o); }
#pragma unroll
        for (int dt = 0; dt < 4; ++dt) {
#pragma unroll
            for (int q = 0; q < 4; ++q)
#pragma unroll
                for (int j = 0; j < 4; ++j) S[dt][4 * q + j] *= dc[dt][q][j];
#pragma unroll
            for (int st = 0; st < 2; ++st) S[dt] = mfma32(fe[dt][st], fv[st], S[dt]);
        }
        float ssum = 0.f;
#pragma unroll
        for (int i = 0; i < 16; ++i) ssum += o[i] * o[i];
        ssum += __shfl_xor(ssum, 32, 64);
#pragma unroll
        for (int q = 0; q < 4; ++q) *(LAS f32x4*)(B + HG_OB + r * 528 + (sl * 32 + 8 * q + 4 * hh) * 4) = (f32x4){o[4 * q], o[4 * q + 1], o[4 * q + 2], o[4 * q + 3]};
        if (hh == 0) ((LAS float*)(B + HG_SS))[sl * 32 + r] = ssum;
    }
    HG_BARRIER();
}
DI void hgrn_chain(int b, int h, const Params& P, LAS unsigned char* lds) {
    const int tid = threadIdx.x;
    HgCtx C;
    C.wave = __builtin_amdgcn_readfirstlane(tid >> 6); C.lane = tid & 63; C.r = C.lane & 31; C.hh = C.lane >> 5;
    C.rowbase = (size_t)b * SEQ; C.hbase = (size_t)(b * 4 + h) * 2048 * 128; C.hc = h * 128; C.rsw = ((C.r >> 3) & 3) << 5;
    const int ptid = tid & 255;
    C.pq = C.lane & 3; C.pd0 = (((ptid >> 6) * 16) + (C.lane >> 2)) * 2;
    C.pv2 = ptid & 63; C.ptq = ptid >> 6; C.ft = ptid >> 3; C.fv0 = (ptid & 7) * 16;
    __syncthreads();
    if (tid < 128) ((LAS float*)(lds + HG_GN))[tid] = P.gnorm_g[C.hc + tid];
    if (C.wave >= 4) {
        unsigned fgA[8], fgB[8], fgC[8]; unsigned qA[8], qB[8], qC[8], wA[8], wB[8], wC[8];
        u32x4 gA0 = {0u, 0u, 0u, 0u}, gA1 = gA0, gB0 = gA0, gB1 = gA0, gC0 = gA0, gC1 = gA0;
#pragma unroll
        for (int t = 0; t < 8; ++t) { fgA[t] = 0u; qA[t] = 0u; wA[t] = 0u; }
#pragma unroll
        for (int pb = 0; pb < 2; ++pb) {
            const size_t t0 = C.hbase + (size_t)pb * 32 * 128;
            const unsigned short* zfp = P.zf + t0 + C.pq * 8 * 128 + C.pd0;
            const bf16_t* zqp = P.zq + t0 + C.pq * 8 * 128 + C.pd0;
            const unsigned* zip = (const unsigned*)(P.zi + t0 + C.ptq * 8 * 128) + C.pv2;
#pragma unroll
            for (int t = 0; t < 8; ++t) {
                if (pb == 0) { fgB[t] = *(const unsigned*)(zfp + t * 128); qB[t] = *(const unsigned*)(zqp + t * 128); wB[t] = zip[t * 64]; }
                else { fgC[t] = *(const unsigned*)(zfp + t * 128); qC[t] = *(const unsigned*)(zqp + t * 128); wC[t] = zip[t * 64]; } }
        }
#pragma unroll 1
        for (int it = 0; it < 66; it += 3) {
            hg_prep_iter(it,     C, P, lds, fgA, qA, wA, gA0, gA1, fgB, qB, wB, gB0, gB1);
            hg_prep_iter(it + 1, C, P, lds, fgB, qB, wB, gB0, gB1, fgC, qC, wC, gC0, gC1);
            hg_prep_iter(it + 2, C, P, lds, fgC, qC, wC, gC0, gC1, fgA, qA, wA, gA0, gA1);
        }
    } else {
        f32x16 S[4];
#pragma unroll
        for (int dt = 0; dt < 4; ++dt)
#pragma unroll
            for (int i = 0; i < 16; ++i) S[dt][i] = 0.f;
#pragma unroll 1
        for (int it = 0; it < 66; ++it) hg_state_iter(it, C, lds, S);
        float* so = P.st_prompt + ((size_t)(b * 4 + h) * 128) * 128 + C.wave * 32 + C.r;
#pragma unroll
        for (int dt = 0; dt < 4; ++dt)
#pragma unroll
            for (int i = 0; i < 16; ++i) so[(size_t)(32 * dt + crow(i, C.hh)) * 128] = S[dt][i];
    }
}

DI void hgrn_sample(int b, int h, const Params& P, LAS unsigned char* lds) {
    int tid = threadIdx.x;
    asm volatile("" : "+v"(tid));
    LAS float* Q = (LAS float*)lds; LAS float* F = Q + 2048; LAS float* K = F + 2048; LAS float* VV = K + 2048; LAS float* OP = VV + 2048;
    const int hc = h * 128;
    __syncthreads();
    for (int e = tid; e < 2048; e += NTHREADS) { const int t = e >> 7, d = e & 127; const size_t row = (size_t)MP + b * 16 + t;
        const size_t ho = hoff((int)row, h) + d;
        const float f = 1.f - (float)__builtin_bit_cast(_Float16, P.zf[ho]);
        Q[e] = bf1(P.zq[ho]); F[e] = f; K[e] = 1.f - f; VV[e] = bf1(P.zi[ho]); }
    __syncthreads();
    { const int v = tid & 127, dq = tid >> 7;
      float S[32];
      const float* sin_ = P.state_in + ((size_t)(b * 4 + h) * 128 + dq * 32) * 128 + v;
#pragma unroll
      for (int dd = 0; dd < 32; ++dd) S[dd] = sin_[(size_t)dd * 128];
      for (int t = 0; t < 16; ++t) { const float vvv = VV[t * 128 + v]; float op = 0.f;
#pragma unroll
          for (int dd = 0; dd < 32; ++dd) { const int d = dq * 32 + dd; S[dd] = F[t * 128 + d] * S[dd] + K[t * 128 + d] * vvv; op += S[dd] * Q[t * 128 + d]; }
          OP[(t * 4 + dq) * 128 + v] = op; }
      float* so = P.st_sample + ((size_t)(b * 4 + h) * 128 + dq * 32) * 128 + v;
#pragma unroll
      for (int dd = 0; dd < 32; ++dd) so[(size_t)dd * 128] = S[dd]; }
    __syncthreads();
    { const int t = tid >> 5, v = (tid & 31) * 4; const size_t row = (size_t)MP + b * 16 + t;
      float o[4]; float ss = 0.f;
#pragma unroll
      for (int j = 0; j < 4; ++j) { o[j] = OP[(t * 4 + 0) * 128 + v + j] + OP[(t * 4 + 1) * 128 + v + j] + OP[(t * 4 + 2) * 128 + v + j] + OP[(t * 4 + 3) * 128 + v + j]; ss += o[j] * o[j]; }
#pragma unroll
      for (int m = 16; m >= 1; m >>= 1) ss += __shfl_xor(ss, m, 64);
      const float rstd = rsqrtf(ss * (1.f / 128.f) + EPS);
      const u32x2 gb = *(const u32x2*)(P.zgb + hoff((int)row, h) + v);
      const float sg[4] = {bflo(gb.x), bfhi(gb.x), bflo(gb.y), bfhi(gb.y)};
#pragma unroll
      for (int j = 0; j < 4; ++j) o[j] = o[j] * rstd * P.gnorm_g[hc + v + j] * sg[j];
      u32x2 w; w.x = pk2(o[0], o[1]); w.y = pk2(o[2], o[3]);
      *(u32x2*)(P.mix + row * 1024 + 512 + hc + v) = w; }
}

__global__ void __launch_bounds__(NTHREADS, 2) fwd_mega(Params P) {
    extern __shared__ __attribute__((aligned(16))) unsigned char lds_raw[];
    LAS unsigned char* lds = (LAS unsigned char*)lds_raw;
    cg::grid_group grid = cg::this_grid();
    const int G = gridDim.x, bid = blockIdx.x;
    const int lo = P.ph_lo, hi = P.ph_hi;
    if (hi < 0) grid.sync();
    volatile LAS unsigned* bst = (volatile LAS unsigned*)(lds + 140 * 1024 + 64);
    if (threadIdx.x < 2) bst[threadIdx.x] = 0u;
    __syncthreads();
    const XcdBarrier xbar = xcd_barrier_post(P.bar, bst);
#define IN(k) (lo <= (k) && (k) < hi)
#define SEAM(k) do { if (IN(k) && IN((k) + 1)) xcd_barrier(xbar); } while (0)

    if (IN(0)) phase0(P, lds);
    SEAM(0);

    if (IN(1)) {
        for (int w = bid; w < 256; w += G)
            p1_rows(P.x_prompt + (size_t)w * 256 * 1024, P.hb + (size_t)w * 256 * 1024, 256, 16, P.mod + (w >> 3) * 5120, P.norm_g, (LAS float*)lds);
        for (int w = bid; w < 16; w += G)
            p1_rows(P.x_sample + (size_t)w * 16 * 1024, P.hb + ((size_t)MP + w * 16) * 1024, 16, 16, P.mod + (32 + w) * 5120, P.norm_g, (LAS float*)lds);
    }
    SEAM(1);

    if (IN(2)) {
        { const int dly = ((bid >> 3) & 7) * 8 + (bid & 7);
          for (int i = 0; i < dly; ++i) __builtin_amdgcn_s_sleep(8); }
        pg8::Gemm g{P.hb, P.winT, MT, INW, DM}; pg8::StaticOrder S; S.init(MT, INW, G, bid);
        EpiZ E{P.zu, P.zf, P.lb_logits};
        pg8::gemm_phase<EpiZ, pg8::StaticOrder>(lds, g, S, E);
    }
    SEAM(2);

    if (IN(3)) {
        if (bid < 128) hgrn_chain(bid >> 2, bid & 3, P, lds);
        LAS unsigned* qw = (LAS unsigned*)(lds + 140 * 1024);
        for (;;) {
            __syncthreads();
            if (threadIdx.x == 0) *qw = atomicAdd(P.ctr, 1u);
            __syncthreads();
            const int i = (int)*qw;
            if (i >= 512 + 16 + 64) break;
            if (i < 512) gmlp_item(i >> 4, i & 15, P, lds);
            else if (i < 528) gmlp_sample(i - 512, P, lds);
            else { const int q = i - 528; hgrn_sample(q >> 2, q & 3, P, lds); }
        }
    }
    SEAM(3);

    if (IN(4)) {
        for (int i = bid; i < 4 * 64; i += G) sgemm_out_item(P.mix + (size_t)MP * 1024, P.woutT, i & 3, i >> 2, P.xnew, lds);
        __syncthreads();
        pg8::Gemm g{P.mix, P.woutT, MP, DM, DM}; pg8::StaticOrder S; S.init(MP, DM, G, bid);
        EpiOut E{P.xnew};
        pg8::gemm_phase<EpiOut, pg8::StaticOrder>(lds, g, S, E);
    }
    SEAM(4);

    if (IN(5)) {
        for (int w = bid; w < 256; w += G)
            p5_rows(P.x_prompt + (size_t)w * 256 * 1024, P.xnew + (size_t)w * 256 * 1024, P.y_prompt + (size_t)w * 256 * 1024, 256, 16, P.mod + (w >> 3) * 5120, P.g_final, (LAS float*)lds);
        for (int w = bid; w < 16; w += G)
            p5_rows(P.x_sample + (size_t)w * 16 * 1024, P.xnew + ((size_t)MP + w * 16) * 1024, P.y_sample + (size_t)w * 16 * 1024, 16, 16, P.mod + (32 + w) * 5120, P.g_final, (LAS float*)lds);
    }
#undef IN
#undef SEAM
}

#ifndef MK_N_LAUNCHES
#define MK_N_LAUNCHES 1
#endif

extern "C" void kernel_launch(void* const* d_in, const int* in_sizes, int n_in, void* d_out, int out_size, void* d_ws, size_t ws_size, hipStream_t stream) {
    static int grid_blocks = 0;
    if (!grid_blocks) {
        int dev = 0, cus = 0, per_cu = 0;
        hipGetDevice(&dev);
        hipDeviceGetAttribute(&cus, hipDeviceAttributeMultiprocessorCount, dev);
        hipFuncSetAttribute((const void*)fwd_mega, hipFuncAttributeMaxDynamicSharedMemorySize, LDS_BYTES);
        hipOccupancyMaxActiveBlocksPerMultiprocessor(&per_cu, (const void*)fwd_mega, NTHREADS, LDS_BYTES);
        if (per_cu < 1) { fprintf(stderr, "kernel_launch: occupancy query returned %d\n", per_cu); per_cu = 1; }
        (void)hipGetLastError();
        grid_blocks = cus * 1;
        if (ws_size < WS_END) fprintf(stderr, "kernel_launch: workspace too small: %zu < %zu\n", ws_size, (size_t)WS_END);
    }
    Params p{};
    const float* const* in = (const float* const*)d_in;
    p.x_prompt = in[0]; p.x_sample = in[1]; p.c_prompt = in[2]; p.c_sample = in[3]; p.state_in = in[4];
    p.norm_g = in[5]; p.w_ada = in[6]; p.b_ada = in[7]; p.w_in = in[8]; p.ln_v_g = in[9]; p.ln_v_b = in[10];
    p.w_sp = in[11]; p.b_sp = in[12]; p.lb_logits = in[13]; p.gnorm_g = in[14]; p.w_out = in[15]; p.g_final = in[16];
    p.w_ada_f = in[17]; p.b_ada_f = in[18];
    float* out = (float*)d_out;
    p.y_prompt = out; p.y_sample = out + (size_t)MP * 1024; p.st_prompt = p.y_sample + (size_t)MS * 1024;
    p.st_sample = p.st_prompt + (size_t)32 * 4 * 128 * 128; p.v_sample = p.st_sample + (size_t)16 * 4 * 128 * 128;
    unsigned char* ws = (unsigned char*)d_ws;
    p.hb = (bf16_t*)(ws + WS_HB); p.winT = (bf16_t*)(ws + WS_WINT); p.woutT = (bf16_t*)(ws + WS_WOUTT); p.mod = (float*)(ws + WS_MOD);
    p.rowss = (float*)(ws + WS_ROWSS); p.wm = (bf16_t*)(ws + WS_WM);
    bf16_t* zb = (bf16_t*)(ws + WS_ZB); const size_t zs = (size_t)MT * 512;
    p.zu = zb; p.zv = zb + zs; p.zga = zb + 2 * zs; p.zq = zb + 3 * zs; p.zi = zb + 4 * zs; p.zgb = zb + 5 * zs; p.zf = (unsigned short*)(ws + WS_ZF);
    p.mix = (bf16_t*)(ws + WS_MIX); p.xnew = (bf16_t*)(ws + WS_XNEW); p.ctr = (unsigned*)(ws + WS_CTR); p.bar = (unsigned*)(ws + WS_BAR);
    (void)hipMemsetAsync(ws + WS_BAR, 0, WS_BAR_BYTES, stream);
#if MK_N_LAUNCHES == 1
    p.ph_lo = 0; p.ph_hi = 6;
    void* args[] = {&p};
    hipError_t e = hipLaunchCooperativeKernel((const void*)fwd_mega, dim3(grid_blocks), dim3(NTHREADS), args, LDS_BYTES, stream);
    if (e != hipSuccess) fprintf(stderr, "cooperative launch failed: %s (grid %d)\n", hipGetErrorString(e), grid_blocks);
#else
    for (int ph = 0; ph < 6; ++ph) { p.ph_lo = ph; p.ph_hi = ph + 1;
        hipLaunchKernelGGL(fwd_mega, dim3(grid_blocks), dim3(NTHREADS), LDS_BYTES, stream, p); }
#endif
}
```

```cpp
#include <hip/hip_runtime.h>
#include <hip/hip_cooperative_groups.h>
#include <cstdio>
namespace cg = cooperative_groups;

#define LAS __attribute__((address_space(3)))
#define DI __device__ __forceinline__
#define RMAP(r) ((size_t)((((r) >> 4) * bstr) + ((((r) & 7) << 1) | (((r) >> 3) & 1))))
typedef unsigned short bf16_t;
typedef short bf16x8 __attribute__((ext_vector_type(8)));
typedef short s16x4 __attribute__((ext_vector_type(4)));
typedef float f32x4 __attribute__((ext_vector_type(4)));
typedef float f32x2 __attribute__((ext_vector_type(2)));
typedef float f32x16 __attribute__((ext_vector_type(16)));
typedef unsigned u32x4 __attribute__((ext_vector_type(4)));
typedef unsigned u32x2 __attribute__((ext_vector_type(2)));
typedef __bf16 bf2_t __attribute__((ext_vector_type(2)));
typedef _Float16 h2_t __attribute__((ext_vector_type(2)));

constexpr int DM = 1024, SEQ = 2048, MP = 32 * 2048, MS = 256, MT = MP + MS, INW = 3584;
constexpr float EPS = 1e-6f;
constexpr int NTHREADS = 512;

constexpr size_t SZ_ROWS1024_BF = (size_t)MT * 1024 * 2;
constexpr size_t SZ_ROWS512_BF = (size_t)MT * 512 * 2;
constexpr size_t WS_HB = 0;
constexpr size_t WS_WINT = WS_HB + SZ_ROWS1024_BF;
constexpr size_t WS_WOUTT = WS_WINT + (size_t)INW * 1024 * 2;
constexpr size_t WS_MOD = WS_WOUTT + (size_t)1024 * 1024 * 2;
constexpr size_t WS_ROWSS = WS_MOD + (size_t)48 * 5120 * 4;
constexpr size_t WS_WM = WS_ROWSS + (size_t)MT * 4;
constexpr size_t WS_ZB = WS_WM + (size_t)4 * 128 * 128 * 2;
constexpr size_t WS_ZF = WS_ZB + 6 * SZ_ROWS512_BF;
constexpr size_t WS_MIX = WS_ZF + (size_t)MT * 512 * 2;
constexpr size_t WS_XNEW = WS_MIX + SZ_ROWS1024_BF;
constexpr size_t WS_BAR = WS_XNEW + SZ_ROWS1024_BF;
constexpr size_t WS_MODZ = WS_BAR + 16384;
constexpr size_t WS_BAR_BYTES = 16384 + (size_t)48 * 5120 * 4;
constexpr size_t WS_CTR = WS_BAR + 15360;
constexpr size_t WS_END = WS_BAR + WS_BAR_BYTES;

constexpr int LDS_BYTES = 144 * 1024;

struct Params {
    const float* x_prompt; const float* x_sample; const float* c_prompt; const float* c_sample; const float* state_in;
    const float* norm_g; const float* w_ada; const float* b_ada; const float* w_in; const float* ln_v_g; const float* ln_v_b;
    const float* w_sp; const float* b_sp; const float* lb_logits; const float* gnorm_g; const float* w_out; const float* g_final;
    const float* w_ada_f; const float* b_ada_f;
    float* y_prompt; float* y_sample; float* st_prompt; float* st_sample; float* v_sample;
    bf16_t* hb; bf16_t* winT; bf16_t* woutT; float* mod; float* rowss; bf16_t* wm;
    bf16_t* zu; bf16_t* zv; bf16_t* zga; bf16_t* zq; bf16_t* zi; bf16_t* zgb; unsigned short* zf;
    bf16_t* mix; bf16_t* xnew; unsigned* ctr; unsigned* bar;
    int ph_lo, ph_hi;
};

DI unsigned pk2(float lo, float hi) { f32x2 v = {lo, hi}; bf2_t r = __builtin_convertvector(v, bf2_t); return __builtin_bit_cast(unsigned, r); }
DI unsigned pkh2(float lo, float hi) { f32x2 v = {lo, hi}; h2_t r = __builtin_convertvector(v, h2_t); return __builtin_bit_cast(unsigned, r); }
DI f32x2 unpkh2(unsigned u) { return __builtin_convertvector(__builtin_bit_cast(h2_t, u), f32x2); }
DI float bflo(unsigned u) { return __uint_as_float(u << 16); }
DI float bfhi(unsigned u) { return __uint_as_float(u & 0xffff0000u); }
DI float bf1(bf16_t u) { return __uint_as_float(((unsigned)u) << 16); }
DI float fexp(float x) { return __builtin_amdgcn_exp2f(x * 1.44269504089f); }
DI float frcp(float x) { return __builtin_amdgcn_rcpf(x); }
DI float flog(float x) { return __builtin_amdgcn_logf(x) * 0.69314718056f; }
DI float silu_f(float x) { return x * frcp(1.f + fexp(-x)); }
template <int CTRL> DI float dpp_f(float v) { return __builtin_bit_cast(float, __builtin_amdgcn_update_dpp(0, __builtin_bit_cast(int, v), CTRL, 0xf, 0xf, false)); }
DI float wave_sum(float v) {
    v += dpp_f<0x128>(v); v += dpp_f<0x124>(v); v += dpp_f<0x122>(v); v += dpp_f<0x121>(v);
    const int iv = __builtin_bit_cast(int, v);
    const float r0 = __builtin_bit_cast(float, __builtin_amdgcn_readlane(iv, 0)), r1 = __builtin_bit_cast(float, __builtin_amdgcn_readlane(iv, 16));
    const float r2 = __builtin_bit_cast(float, __builtin_amdgcn_readlane(iv, 32)), r3 = __builtin_bit_cast(float, __builtin_amdgcn_readlane(iv, 48));
    return (r0 + r1) + (r2 + r3);
}
DI f32x16 mfma32(bf16x8 a, bf16x8 b, f32x16 c) { return __builtin_amdgcn_mfma_f32_32x32x16_bf16(a, b, c, 0, 0, 0); }
DI int crow(int reg, int h) { return (reg & 3) + 8 * (reg >> 2) + 4 * h; }


#define XB_TMO      128
#define XB_XCNT(j)  (256  + 64 * (j))
#define XB_XSUB(j)  (1280 + 64 * (j))
#define XB_XGEN(j)  (2304 + 64 * (j))
#define XB_TOP      3328
#define XB_TOPGEN   3392
#define XCD_BAR_WORDS 3456
#define XB_SPIN_CAP (1u << 18)
DI unsigned xb_ld(unsigned* p)              { return __hip_atomic_load(p, __ATOMIC_RELAXED, __HIP_MEMORY_SCOPE_AGENT); }
DI unsigned xb_add(unsigned* p, unsigned v) { return __hip_atomic_fetch_add(p, v, __ATOMIC_RELAXED, __HIP_MEMORY_SCOPE_AGENT); }
DI unsigned xb_xcc_id() { return (unsigned)__builtin_amdgcn_s_getreg((3 << 11) | 20) & 0xFu; }
#define XB_SPIN(cond, bar) do { unsigned _sp = 0; while (cond) { __builtin_amdgcn_s_sleep(1); \
    if ((++_sp & 255u) == 0u) { if (xb_ld(&(bar)[XB_TMO])) break; if (_sp > XB_SPIN_CAP) { atomicAdd(&(bar)[XB_TMO], 1u); break; } } } } while (0)
struct XcdBarrier { unsigned* bar; unsigned x; volatile LAS unsigned* st; };
DI XcdBarrier xcd_barrier_post(unsigned* bar, volatile LAS unsigned* st) {
    XcdBarrier b; b.bar = bar; b.x = xb_xcc_id(); b.st = st;
    if (threadIdx.x == 0) (void)xb_add(&bar[XB_XCNT(b.x)], 1u);
    return b;
}
DI void xcd_barrier_complete(unsigned* bar, unsigned x, unsigned& nloc, unsigned& nx) {
    const unsigned G = gridDim.x * gridDim.y * gridDim.z;
    unsigned sum, cnt, mine, sp = 0u;
    for (;;) {
        sum = 0u; cnt = 0u; mine = 0u;
#pragma unroll
        for (unsigned j = 0; j < 16; ++j) { const unsigned c = xb_ld(&bar[XB_XCNT(j)]); sum += c; cnt += (c > 0u) ? 1u : 0u; mine = (j == x) ? c : mine; }
        if (sum == G) break;
        __builtin_amdgcn_s_sleep(1);
        if ((++sp & 255u) == 0u) { if (xb_ld(&bar[XB_TMO])) break; if (sp > XB_SPIN_CAP) { atomicAdd(&bar[XB_TMO], 1u); break; } }
    }
    nloc = mine > 0u ? mine : 1u; nx = cnt > 0u ? cnt : 1u;
}
DI void xcd_barrier(const XcdBarrier& b) {
    asm volatile("s_waitcnt vmcnt(0)" ::: "memory");
    __syncthreads();
    if (threadIdx.x == 0) {
        unsigned* bar = b.bar;
        __builtin_amdgcn_s_waitcnt(0);
        unsigned nloc = b.st[0], nx = b.st[1];
        if (nloc == 0u) { xcd_barrier_complete(bar, b.x, nloc, nx); b.st[0] = nloc; b.st[1] = nx; }
        const unsigned old = xb_add(&bar[XB_XSUB(b.x)], 1u);
        const unsigned gen = old / nloc;
        if (old + 1u == (gen + 1u) * nloc) {
            __builtin_amdgcn_fence(__ATOMIC_RELEASE, "agent");
            asm volatile("s_waitcnt vmcnt(0)" ::: "memory");
            const unsigned og = xb_add(&bar[XB_TOP], 1u);
            const unsigned tg = og / nx;
            if (og + 1u == (tg + 1u) * nx) xb_add(&bar[XB_TOPGEN], 1u);
            else XB_SPIN(xb_ld(&bar[XB_TOPGEN]) == tg, bar);
            __builtin_amdgcn_fence(__ATOMIC_ACQUIRE, "agent");
            xb_add(&bar[XB_XGEN(b.x)], 1u);
            asm volatile("s_waitcnt vmcnt(0)" ::: "memory");
        } else {
            XB_SPIN(xb_ld(&bar[XB_XGEN(b.x)]) == gen, bar);
            __builtin_amdgcn_fence(__ATOMIC_ACQUIRE, "agent");
            asm volatile("s_waitcnt vmcnt(0)" ::: "memory");
        }
    }
    __syncthreads();
}

namespace pg8 {
constexpr int BM = 256, BK = 64, HALF = 128, HTB = HALF * BK * 2, STAGE_BYTES = 8 * HTB, NXCD = 8, WGM = 8;
DI int lds_byte(int r, int c) { const int st = (r >> 4) * 2 + (c >> 5), rr = r & 15, cc = c & 31, ob = rr * 64 + cc * 2; return st * 1024 + (ob ^ (((ob >> 9) & 1) << 5)); }
DI void stage_rc(int b, int& R, int& C) { const int st = b / 1024, sb = b % 1024, swz = sb ^ (((sb >> 9) & 1) << 5); R = (st >> 1) * 16 + swz / 64; C = (st & 1) * 32 + (swz % 64) / 2; }
DI int perm32(int rho) { const int n = rho >> 4, i = rho & 15; return 8 * (i >> 2) + 4 * n + (i & 3); }
struct Unit { int pm, pn; };
struct Gemm { const bf16_t* A; const bf16_t* Bt; int M, N, K; };
struct StaticOrder {
    int nM, nN, nwg, G, c;
    DI void init(int M, int N, int G_, int c_) { nM = M / BM; nN = N / BM; nwg = nM * nN; G = G_; c = c_; }
    DI bool next(int i, Unit& u) const {
        const long L = (long)i * G + c; if (L >= nwg) return false;
        int wgid = (int)L; { const int q = nwg / NXCD, r = nwg % NXCD, xcd = wgid % NXCD, off = wgid / NXCD; wgid = (xcd < r ? xcd * (q + 1) : r * (q + 1) + (xcd - r) * q) + off; }
        const int nig = WGM * nN, gid = wgid / nig, fm = gid * WGM, gsz = (nM - fm) < WGM ? (nM - fm) : WGM;
        u.pm = fm + ((wgid % nig) % gsz); u.pn = (wgid % nig) / gsz; return true;
    }
};

template <class Epi, class Sched>
DI void gemm_phase(LAS unsigned char* lds, const Gemm g, const Sched& S, const Epi& E) {
    const int tid = threadIdx.x, wid = __builtin_amdgcn_readfirstlane(tid >> 6), lane = tid & 63, wr = wid >> 2, wc = wid & 3, fr = lane & 15, fq = lane >> 4;
    const int K = g.K, nt = K / BK;
    unsigned voffA[2], voffB[2];
#pragma unroll
    for (int i = 0; i < 2; ++i) { int R, C; stage_rc(tid * 16 + i * 8192, R, C); const int Rb = Epi::PERM ? ((R & ~31) + perm32(R & 31)) : R;
        voffA[i] = (unsigned)(R * K + C) * 2u; voffB[i] = (unsigned)(Rb * K + C) * 2u; }
    const size_t kstep = (size_t)(BK * 2);
    const size_t hstep = (size_t)HALF * K * 2;
    const size_t tstep = 2 * hstep;
    const unsigned ldsw = (unsigned)wid * 1024u;
    const int aoff = lds_byte(wr * 64 + fr, fq * 8), boff = lds_byte(wc * 32 + fr, fq * 8);
#define PG8_SA(b, h) (((b) * 2 + (h)) * HTB)
#define PG8_SB(b, h) ((4 + (b) * 2 + (h)) * HTB)
#define PG8_STAGE(bufoff, gbase, voff) do { _Pragma("unroll") for (int _i = 0; _i < 2; ++_i) \
        __builtin_amdgcn_global_load_lds((const unsigned*)((const char*)(gbase) + (voff)[_i]), (LAS unsigned*)(lds + (bufoff) + ldsw + _i * 8192), 16, 0, 0); } while (0)
#define PG8_LDA(dst, b, h) do { _Pragma("unroll") for (int m = 0; m < 4; ++m) _Pragma("unroll") for (int k = 0; k < 2; ++k) dst[m][k] = *(const LAS bf16x8*)(lds + PG8_SA(b, h) + aoff + m * 2048 + k * 1024); } while (0)
#define PG8_LDB(dst, b, h) do { _Pragma("unroll") for (int n = 0; n < 2; ++n) _Pragma("unroll") for (int k = 0; k < 2; ++k) dst[n][k] = *(const LAS bf16x8*)(lds + PG8_SB(b, h) + boff + n * 2048 + k * 1024); } while (0)
#define PG8_MMA(ai, bj, At, Bt) do { __builtin_amdgcn_s_setprio(1); _Pragma("unroll") for (int m = 0; m < 4; ++m) _Pragma("unroll") for (int n = 0; n < 2; ++n) _Pragma("unroll") for (int k = 0; k < 2; ++k) \
        acc[ai][bj][m][n] = __builtin_amdgcn_mfma_f32_16x16x32_bf16(Bt[n][k], At[m][k], acc[ai][bj][m][n], 0, 0, 0); __builtin_amdgcn_s_setprio(0); } while (0)
#define PG8_WAIT_V(n) asm volatile("s_waitcnt vmcnt(" #n ")" ::: "memory")
#define PG8_WAIT_L(n) asm volatile("s_waitcnt lgkmcnt(" #n ")" ::: "memory")
#define PG8_BAR __builtin_amdgcn_s_barrier()
#define PG8_SCHED __builtin_amdgcn_sched_barrier(0)
    Unit cur, nxt; int ui = 0;
    if (!S.next(0, cur)) return;
    f32x4 acc[2][2][4][2];
#pragma unroll
    for (int a = 0; a < 2; ++a)
#pragma unroll
        for (int b = 0; b < 2; ++b)
#pragma unroll
            for (int m = 0; m < 4; ++m)
#pragma unroll
                for (int n = 0; n < 2; ++n) acc[a][b][m][n] = (f32x4){0.f, 0.f, 0.f, 0.f};
    bf16x8 At[4][2], B0[2][2], B1[2][2];
    const char* cA = (const char*)g.A + (size_t)cur.pm * tstep; const char* cB = (const char*)g.Bt + (size_t)cur.pn * tstep;
    PG8_STAGE(PG8_SB(0, 0), cB, voffB); PG8_STAGE(PG8_SA(0, 0), cA, voffA); PG8_STAGE(PG8_SB(0, 1), cB + hstep, voffB); PG8_STAGE(PG8_SA(0, 1), cA + hstep, voffA);
    if (wr == 1) PG8_BAR;
    PG8_WAIT_V(4); PG8_BAR;
    PG8_STAGE(PG8_SB(1, 0), cB + kstep, voffB); PG8_STAGE(PG8_SA(1, 0), cA + kstep, voffA); PG8_STAGE(PG8_SB(1, 1), cB + hstep + kstep, voffB);
    PG8_WAIT_V(6); PG8_BAR;
    for (;;) {
        const bool has_next = S.next(ui + 1, nxt);
        const char* nA = has_next ? (const char*)g.A + (size_t)nxt.pm * tstep : cA; const char* nB = has_next ? (const char*)g.Bt + (size_t)nxt.pn * tstep : cB;
        for (int t = 0; t < nt; t += 2) {
            const bool last = (t == nt - 2);
            const char* a1 = cA + (size_t)(t + 1) * kstep;
            const char* a2 = last ? nA : cA + (size_t)(t + 2) * kstep; const char* b2 = last ? nB : cB + (size_t)(t + 2) * kstep;
            const char* a3 = a2 + kstep; const char* b3 = b2 + kstep;
            PG8_LDB(B0, 0, 0); PG8_SCHED; PG8_LDA(At, 0, 0); PG8_STAGE(PG8_SA(1, 1), a1 + hstep, voffA);
            PG8_WAIT_L(8); PG8_BAR; PG8_WAIT_L(0); PG8_MMA(0, 0, At, B0); PG8_BAR; PG8_SCHED;
            PG8_LDB(B1, 0, 1); PG8_STAGE(PG8_SB(0, 0), b2, voffB);
            PG8_BAR; PG8_WAIT_L(0); PG8_MMA(0, 1, At, B1); PG8_BAR;
            PG8_LDA(At, 0, 1); PG8_STAGE(PG8_SA(0, 0), a2, voffA);
            PG8_BAR; PG8_WAIT_L(0); PG8_MMA(1, 0, At, B0); PG8_BAR; PG8_SCHED;
            PG8_STAGE(PG8_SB(0, 1), b2 + hstep, voffB);
            PG8_WAIT_V(6); PG8_BAR; PG8_MMA(1, 1, At, B1); PG8_BAR;
            PG8_LDB(B0, 1, 0); PG8_SCHED; PG8_LDA(At, 1, 0); PG8_STAGE(PG8_SA(0, 1), a2 + hstep, voffA);
            PG8_WAIT_L(8); PG8_BAR; PG8_WAIT_L(0); PG8_MMA(0, 0, At, B0); PG8_BAR; PG8_SCHED;
            PG8_LDB(B1, 1, 1); PG8_STAGE(PG8_SB(1, 0), b3, voffB);
            PG8_BAR; PG8_WAIT_L(0); PG8_MMA(0, 1, At, B1); PG8_BAR;
            PG8_LDA(At, 1, 1); PG8_STAGE(PG8_SA(1, 0), a3, voffA);
            PG8_BAR; PG8_WAIT_L(0); PG8_MMA(1, 0, At, B0); PG8_BAR; PG8_SCHED;
            PG8_STAGE(PG8_SB(1, 1), b3 + hstep, voffB);
            PG8_WAIT_V(6); PG8_BAR; PG8_MMA(1, 1, At, B1); PG8_BAR;
        }
        E(acc, cur, wr, wc, fr, fq);
        if (!has_next) break;
#pragma unroll
        for (int a = 0; a < 2; ++a)
#pragma unroll
            for (int b = 0; b < 2; ++b)
#pragma unroll
                for (int m = 0; m < 4; ++m)
#pragma unroll
                    for (int n = 0; n < 2; ++n) acc[a][b][m][n] = (f32x4){0.f, 0.f, 0.f, 0.f};
        cur = nxt; cA = nA; cB = nB; ++ui;
    }
    PG8_WAIT_V(0);
    if (wr == 0) PG8_BAR;
    PG8_BAR;
#undef PG8_SA
#undef PG8_SB
#undef PG8_STAGE
#undef PG8_LDA
#undef PG8_LDB
#undef PG8_MMA
#undef PG8_WAIT_V
#undef PG8_WAIT_L
#undef PG8_BAR
#undef PG8_SCHED
}
}

DI size_t hoff(int row, int h) {
    return row < MP ? ((size_t)((row >> 11) * 4 + h) * 2048 + (row & 2047)) * 128
                    : (size_t)MP * 512 + ((size_t)(((row - MP) >> 4) * 4 + h) * 16 + ((row - MP) & 15)) * 128;
}
struct EpiZ {
    static constexpr bool PERM = true;
    bf16_t* zb; unsigned short* zf; const float* lbl;
    DI void operator()(const f32x4 (&acc)[2][2][4][2], const pg8::Unit& u, int wr, int wc, int fr, int fq) const {
        const int row0 = u.pm * 256 + wr * 64 + fr;
        if (u.pn < 4) {
            const int c0 = u.pn * 128 + wc * 32 + 8 * fq;
#pragma unroll
            for (int ai = 0; ai < 2; ++ai)
#pragma unroll
                for (int m = 0; m < 4; ++m) { bf16_t* rowp = zb + (size_t)(row0 + ai * 128 + m * 16) * 512 + c0;
                    f32x4 v0 = acc[ai][0][m][0], v1 = acc[ai][0][m][1]; const f32x4 g0 = acc[ai][1][m][0], g1 = acc[ai][1][m][1];
#pragma unroll
                    for (int j = 0; j < 4; ++j) { v0[j] *= silu_f(g0[j]); v1[j] *= silu_f(g1[j]); }
                    u32x4 w; w.x = pk2(v0[0], v0[1]); w.y = pk2(v0[2], v0[3]); w.z = pk2(v1[0], v1[1]); w.w = pk2(v1[2], v1[3]);
                    *(u32x4*)(rowp) = w; }
            return;
        }
        const int sec = (u.pn >> 1) - 1;
        const int cbase = (u.pn & 1) * 256 + wc * 32 + 8 * fq;
        const bool smp = (u.pm == MP / 256);
        const int hMS = smp ? 4 * 16 * 128 : 16 * 128, hBS = smp ? 16 * 128 : 2048 * 128;
        const size_t hLB = hoff(u.pm * 256 + wr * 64 + fr, (u.pn & 1) * 2) + wc * 32 + 8 * fq;
        if (sec == 3) {
            float lb[2][8];
#pragma unroll
            for (int bj = 0; bj < 2; ++bj)
#pragma unroll
                for (int j = 0; j < 8; ++j) { const int c = cbase + bj * 128 + j; lb[bj][j] = 1.f / (1.f + __expf(lbl[512 + c] - lbl[c])); }
#pragma unroll
            for (int ai = 0; ai < 2; ++ai)
#pragma unroll
                for (int m = 0; m < 4; ++m) {
#pragma unroll
                    for (int bj = 0; bj < 2; ++bj) { float k0[4], k1[4];
                        unsigned short* rowp = zf + hLB + (size_t)((ai * 8 + m) * hMS + bj * hBS) - bj * 128;
#pragma unroll
                        for (int j = 0; j < 4; ++j) {
                            k0[j] = (1.f - lb[bj][j]) * frcp(1.f + fexp(acc[ai][bj][m][0][j])); k1[j] = (1.f - lb[bj][4 + j]) * frcp(1.f + fexp(acc[ai][bj][m][1][j])); }
                        u32x4 w; w.x = pkh2(k0[0], k0[1]); w.y = pkh2(k0[2], k0[3]); w.z = pkh2(k1[0], k1[1]); w.w = pkh2(k1[2], k1[3]);
                        *(u32x4*)(rowp + bj * 128) = w; } }
        } else {
            const bool act = (sec == 2) || (sec == 5);
            bf16_t* base = zb + (size_t)(sec == 1 ? 1 : (sec == 2 ? 3 : (sec == 4 ? 4 : 5))) * ((size_t)MT * 512);
#pragma unroll
            for (int ai = 0; ai < 2; ++ai)
#pragma unroll
                for (int m = 0; m < 4; ++m) { const int row = row0 + ai * 128 + m * 16;
#pragma unroll
                    for (int bj = 0; bj < 2; ++bj) { f32x4 v0 = acc[ai][bj][m][0], v1 = acc[ai][bj][m][1];
                        bf16_t* rowp = (sec == 1 ? base + (size_t)row * 512 + cbase : base + hLB + (size_t)((ai * 8 + m) * hMS + bj * hBS) - bj * 128);
                        if (act) {
#pragma unroll
                            for (int j = 0; j < 4; ++j) { v0[j] = silu_f(v0[j]); v1[j] = silu_f(v1[j]); } }
                        u32x4 w; w.x = pk2(v0[0], v0[1]); w.y = pk2(v0[2], v0[3]); w.z = pk2(v1[0], v1[1]); w.w = pk2(v1[2], v1[3]);
                        *(u32x4*)(rowp + bj * 128) = w; } }
        }
    }
};

struct EpiOut {
    static constexpr bool PERM = true;
    bf16_t* ob;
    DI void operator()(const f32x4 (&acc)[2][2][4][2], const pg8::Unit& u, int wr, int wc, int fr, int fq) const {
        const int row0 = u.pm * 256 + wr * 64 + fr, col0 = u.pn * 256 + wc * 32 + 8 * fq;
#pragma unroll
        for (int ai = 0; ai < 2; ++ai)
#pragma unroll
            for (int m = 0; m < 4; ++m) { bf16_t* rowp = ob + (size_t)(row0 + ai * 128 + m * 16) * 1024 + col0;
#pragma unroll
                for (int bj = 0; bj < 2; ++bj) { const f32x4 v0 = acc[ai][bj][m][0], v1 = acc[ai][bj][m][1];
                    u32x4 w; w.x = pk2(v0[0], v0[1]); w.y = pk2(v0[2], v0[3]); w.z = pk2(v1[0], v1[1]); w.w = pk2(v1[2], v1[3]);
                    *(u32x4*)(rowp + bj * 128) = w; } }
    }
};


DI void sgemm_out_item(const bf16_t* __restrict__ A, const bf16_t* __restrict__ Bt, int rb, int cb, bf16_t* __restrict__ ob, LAS unsigned char* lds) {
    const int tid = threadIdx.x, wave = __builtin_amdgcn_readfirstlane(tid >> 6), lane = tid & 63, l16 = lane & 15, kg = lane >> 4;
    const int mt = wave & 3, kh = wave >> 2;
    const bf16_t* ap = A + (size_t)(rb * 64 + mt * 16 + l16) * 1024 + kh * 512 + kg * 8;
    const bf16_t* bp = Bt + (size_t)(cb * 16 + l16) * 1024 + kh * 512 + kg * 8;
    bf16x8 af[16], bfv[16];
#pragma unroll
    for (int ks = 0; ks < 16; ++ks) { af[ks] = *(const bf16x8*)(ap + ks * 32); bfv[ks] = *(const bf16x8*)(bp + ks * 32); }
    f32x4 acc = {0.f, 0.f, 0.f, 0.f};
#pragma unroll
    for (int ks = 0; ks < 16; ++ks) acc = __builtin_amdgcn_mfma_f32_16x16x32_bf16(bfv[ks], af[ks], acc, 0, 0, 0);
    __syncthreads();
    if (kh == 1) *(LAS f32x4*)(lds + (mt * 64 + lane) * 16) = acc;
    __syncthreads();
    if (kh == 0) { acc += *(const LAS f32x4*)(lds + (mt * 64 + lane) * 16);
        u32x2 w; w.x = pk2(acc[0], acc[1]); w.y = pk2(acc[2], acc[3]);
        *(u32x2*)(ob + ((size_t)MP + rb * 64 + mt * 16 + l16) * 1024 + cb * 16 + 4 * kg) = w; }
}

DI void p0_transpose_tile(const float* __restrict__ W, int ldw, bf16_t* __restrict__ Wt, int k0, int n0, int nsrc, LAS float* tile) {
    const int tid = threadIdx.x;
    { const int nn = tid & 63, kg = tid >> 6;
#pragma unroll
      for (int i = 0; i < 8; ++i) { const int kk = kg * 8 + i; tile[kk * 65 + nn] = W[(size_t)(k0 + kk) * ldw + nsrc + nn]; } }
    __syncthreads();
    { const int kp = tid & 31, ng = tid >> 5;
#pragma unroll
      for (int i = 0; i < 4; ++i) { const int nn = ng * 4 + i; const unsigned w = pk2(tile[(2 * kp) * 65 + nn], tile[(2 * kp + 1) * 65 + nn]);
          *(unsigned*)(Wt + (size_t)(n0 + nn) * 1024 + k0 + 2 * kp) = w; } }
    __syncthreads();
}

DI void p0_mod_item(int it, const Params& P, LAS float* sm) {
    const int tid = threadIdx.x, cg = tid & 7, rg = (tid >> 3) & 3, kq = tid >> 5;
    const int cb = it >> 2, kc = it & 3, kbase = kc * 256;
    const int j0 = cb * 32; const float* W; int ldw; const float* bias; int jc;
    if (j0 < 3072) { W = P.w_ada; ldw = 3072; bias = P.b_ada; jc = j0; } else { W = P.w_ada_f; ldw = 2048; bias = P.b_ada_f; jc = j0 - 3072; }
    const float* Wp = W + (size_t)(kbase + kq * 16) * ldw + jc + cg * 4;
    f32x4 w[16];
#pragma unroll
    for (int kk = 0; kk < 16; ++kk) w[kk] = *(const f32x4*)(Wp + (size_t)kk * ldw);
    f32x4 acc[12];
#pragma unroll
    for (int r = 0; r < 12; ++r) acc[r] = (f32x4){0.f, 0.f, 0.f, 0.f};
    __syncthreads();
    for (int e = tid; e < 48 * 256; e += NTHREADS) { const int r = e >> 8, kk = e & 255;
        const float x = (r < 32) ? P.c_prompt[r * 1024 + kbase + kk] : P.c_sample[(r - 32) * 1024 + kbase + kk];
        sm[kk * 52 + r] = silu_f(x); }
    __syncthreads();
#pragma unroll
    for (int half = 0; half < 2; ++half) {
#pragma unroll
        for (int k8 = 0; k8 < 8; ++k8) { const int kk = half * 8 + k8, k = kq * 16 + kk; const f32x4 wv = w[kk];
#pragma unroll
            for (int r4 = 0; r4 < 3; ++r4) { const f32x4 sv = *(const LAS f32x4*)(sm + k * 52 + rg * 12 + r4 * 4);
                acc[r4 * 4 + 0] += wv * sv[0]; acc[r4 * 4 + 1] += wv * sv[1]; acc[r4 * 4 + 2] += wv * sv[2]; acc[r4 * 4 + 3] += wv * sv[3]; } }
        __builtin_amdgcn_sched_barrier(0);
    }
    __syncthreads();
#pragma unroll
    for (int r = 0; r < 12; ++r) *(LAS f32x4*)(sm + (kq * 48 + rg * 12 + r) * 32 + cg * 4) = acc[r];
    __syncthreads();
    for (int e = tid; e < 48 * 32; e += NTHREADS) { const int r = e >> 5, cc = e & 31; float sacc = (kc == 0) ? bias[jc + cc] : 0.f;
#pragma unroll
        for (int q = 0; q < 16; ++q) sacc += sm[(q * 48 + r) * 32 + cc];
        atomicAdd(P.mod + r * 5120 + j0 + cc, sacc); }
    __syncthreads();
}

DI void phase0(const Params& P, LAS unsigned char* lds) {
    const int tid = threadIdx.x, G = gridDim.x, bid = blockIdx.x;
    LAS float* sm = (LAS float*)lds;
    for (int e = bid * NTHREADS + tid; e < 4 * 128 * 128; e += G * NTHREADS) { const int i = (e >> 7) & 127, j = e & 127;
        const float w = ((j >> 6) <= (i >> 6)) ? P.w_sp[e] : 0.f; P.wm[e] = (bf16_t)(pk2(w, 0.f) & 0xffffu); }
    constexpr int N_MOD = 640, N_TIN = 16 * 56, N_TOUT = 16 * 16;
    for (int it = bid; it < N_MOD; it += G) p0_mod_item(it, P, sm);
    LAS unsigned* qw = (LAS unsigned*)(lds + 140 * 1024);
    for (;;) {
        __syncthreads();
        if (tid == 0) *qw = atomicAdd(P.ctr + 2, 2u);
        __syncthreads();
        const int q0 = (int)*qw;
        if (q0 >= N_TIN + N_TOUT) break;
#pragma unroll 1
        for (int q = q0; q < q0 + 2 && q < N_TIN + N_TOUT; ++q) {
            if (q < N_TIN) { const int n0 = (q >> 4) * 64;
                const int src = (n0 < 1024) ? (((n0 & 255) < 128) ? (n0 >> 8) * 128 + (n0 & 127) : 1024 + (n0 >> 8) * 128 + (n0 & 127)) : (n0 < 1536 ? n0 - 512 : n0);
                p0_transpose_tile(P.w_in, INW, P.winT, (q & 15) * 64, n0, src, sm); }
            else { const int q2 = q - N_TIN; p0_transpose_tile(P.w_out, 1024, P.woutT, (q2 & 15) * 64, (q2 >> 4) * 64, (q2 >> 4) * 64, sm); }
        }
    }
}

DI void p1_rows(const float* __restrict__ xrows, bf16_t* __restrict__ hrows, int nrows, int bstr, const float* modb, const float* norm_g, LAS float* sm) {
    const int tid = threadIdx.x, wave = tid >> 6, lane = tid & 63;
    __syncthreads();
    for (int k = tid; k < 1024; k += NTHREADS) { sm[k] = norm_g[k] * (1.f + modb[1024 + k]); sm[1024 + k] = modb[k]; }
    __syncthreads();
    f32x4 cA[4], cB[4];
#pragma unroll
    for (int q = 0; q < 4; ++q) { const int o = q * 256 + lane * 4; cA[q] = *(const LAS f32x4*)(sm + o); cB[q] = *(const LAS f32x4*)(sm + 1024 + o); }
    f32x4 a[2][4];
#pragma unroll
    for (int u = 0; u < 2; ++u) { const float* xr = xrows + RMAP(wave + 8 * u) * 1024 + lane * 4;
#pragma unroll
        for (int q = 0; q < 4; ++q) a[u][q] = *(const f32x4*)(xr + q * 256); }
    for (int r = wave; r < nrows; r += 16) {
        f32x4 nx[2][4];
        const int rn = (r + 16 < nrows) ? r + 16 : r;
#pragma unroll
        for (int u = 0; u < 2; ++u) { const float* xr = xrows + RMAP(rn + 8 * u) * 1024 + lane * 4;
#pragma unroll
            for (int q = 0; q < 4; ++q) nx[u][q] = *(const f32x4*)(xr + q * 256); }
#pragma unroll
        for (int u = 0; u < 2; ++u) {
            float ss = 0.f;
#pragma unroll
            for (int q = 0; q < 4; ++q)
#pragma unroll
                for (int j = 0; j < 4; ++j) ss += a[u][q][j] * a[u][q][j];
            ss = wave_sum(ss);
            const float rstd = rsqrtf(ss * (1.f / 1024.f) + EPS);
            bf16_t* hr = hrows + RMAP(r + 8 * u) * 1024 + lane * 4;
#pragma unroll
            for (int q = 0; q < 4; ++q) { const f32x4 h = a[u][q] * rstd * cA[q] + cB[q]; u32x2 w; w.x = pk2(h[0], h[1]); w.y = pk2(h[2], h[3]); *(u32x2*)(hr + q * 256) = w; }
        }
#pragma unroll
        for (int u = 0; u < 2; ++u)
#pragma unroll
            for (int q = 0; q < 4; ++q) a[u][q] = nx[u][q];
    }
}

DI void p5_rows(const float* __restrict__ xrows, const bf16_t* __restrict__ orows, float* __restrict__ yrows, int nrows, int bstr, const float* modb, const float* g_final, LAS float* sm) {
    const int tid = threadIdx.x, wave = tid >> 6, lane = tid & 63;
    __syncthreads();
    for (int k = tid; k < 1024; k += NTHREADS) { sm[k] = g_final[k] * (1.f + modb[3072 + 1024 + k]); sm[1024 + k] = modb[3072 + k]; sm[2048 + k] = modb[2048 + k]; }
    __syncthreads();
    f32x4 cA[4], cB[4], cG[4];
#pragma unroll
    for (int q = 0; q < 4; ++q) { const int o = q * 256 + lane * 4; cA[q] = *(const LAS f32x4*)(sm + o); cB[q] = *(const LAS f32x4*)(sm + 1024 + o); cG[q] = *(const LAS f32x4*)(sm + 2048 + o); }
    f32x4 a[2][4]; u32x2 w[2][4];
#pragma unroll
    for (int u = 0; u < 2; ++u) { const float* xr = xrows + RMAP(wave + 8 * u) * 1024 + lane * 4; const bf16_t* orow = orows + RMAP(wave + 8 * u) * 1024 + lane * 4;
#pragma unroll
        for (int q = 0; q < 4; ++q) { a[u][q] = *(const f32x4*)(xr + q * 256); w[u][q] = *(const u32x2*)(orow + q * 256); } }
    for (int r = wave; r < nrows; r += 16) {
        f32x4 nx[2][4]; u32x2 nw[2][4];
        const int rn = (r + 16 < nrows) ? r + 16 : r;
#pragma unroll
        for (int u = 0; u < 2; ++u) { const float* xr = xrows + RMAP(rn + 8 * u) * 1024 + lane * 4; const bf16_t* orow = orows + RMAP(rn + 8 * u) * 1024 + lane * 4;
#pragma unroll
            for (int q = 0; q < 4; ++q) { nx[u][q] = *(const f32x4*)(xr + q * 256); nw[u][q] = *(const u32x2*)(orow + q * 256); } }
#pragma unroll
        for (int u = 0; u < 2; ++u) {
            float ss = 0.f; f32x4 xn[4];
#pragma unroll
            for (int q = 0; q < 4; ++q) { const f32x4 o = {bflo(w[u][q].x), bfhi(w[u][q].x), bflo(w[u][q].y), bfhi(w[u][q].y)};
                xn[q] = a[u][q] + cG[q] * o;
#pragma unroll
                for (int j = 0; j < 4; ++j) ss += xn[q][j] * xn[q][j]; }
            ss = wave_sum(ss);
            const float rstd = rsqrtf(ss * (1.f / 1024.f) + EPS);
            float* yr = yrows + RMAP(r + 8 * u) * 1024 + lane * 4;
#pragma unroll
            for (int q = 0; q < 4; ++q) *(f32x4*)(yr + q * 256) = xn[q] * rstd * cA[q] + cB[q];
        }
#pragma unroll
        for (int u = 0; u < 2; ++u)
#pragma unroll
            for (int q = 0; q < 4; ++q) { a[u][q] = nx[u][q]; w[u][q] = nw[u][q]; }
    }
}

constexpr int GM_VN_PITCH = 272;
constexpr int GM_SP_PITCH = 1040;
DI void gmlp_item(int b, int n, const Params& P, LAS unsigned char* lds) {
    const int tid = threadIdx.x, wave = __builtin_amdgcn_readfirstlane(tid >> 6), lane = tid & 63, r = lane & 31, hh = lane >> 5;
    const size_t row0 = (size_t)b * SEQ + (size_t)n * 128;
    const int g = wave >> 1, ih = wave & 1;
    const bf16_t* wm = P.wm + g * 16384;
    bf16x8 bfr[8][2];
    u32x4 raw[16];
#pragma unroll
    for (int jj = 0; jj < 16; ++jj) raw[jj] = *(const u32x4*)(P.zv + (row0 + wave * 16 + jj) * 512 + lane * 8);
    const f32x4 g0 = *(const f32x4*)(P.ln_v_g + lane * 8), g1 = *(const f32x4*)(P.ln_v_g + lane * 8 + 4), b0 = *(const f32x4*)(P.ln_v_b + lane * 8), b1 = *(const f32x4*)(P.ln_v_b + lane * 8 + 4);
    const float gg[8] = {g0[0], g0[1], g0[2], g0[3], g1[0], g1[1], g1[2], g1[3]}, bb[8] = {b0[0], b0[1], b0[2], b0[3], b1[0], b1[1], b1[2], b1[3]};
    __syncthreads();
#pragma unroll
    for (int half = 0; half < 2; ++half) {
        float vals[8][8];
#pragma unroll
        for (int jj = 0; jj < 8; ++jj) { const u32x4 w = raw[half * 8 + jj];
            const float xs[8] = {bflo(w.x), bfhi(w.x), bflo(w.y), bfhi(w.y), bflo(w.z), bfhi(w.z), bflo(w.w), bfhi(w.w)};
            float s1 = 0.f, s2 = 0.f;
#pragma unroll
            for (int cc = 0; cc < 8; ++cc) { s1 += xs[cc]; s2 += xs[cc] * xs[cc]; }
            s1 = wave_sum(s1); s2 = wave_sum(s2);
            const float mean = s1 * (1.f / 512.f), var = fmaxf(s2 * (1.f / 512.f) - mean * mean, 0.f), rstd = rsqrtf(var + EPS);
#pragma unroll
            for (int cc = 0; cc < 8; ++cc) vals[jj][cc] = (xs[cc] - mean) * rstd * gg[cc] + bb[cc]; }
        const int chunk = (wave * 2 + half) ^ (lane & 15);
#pragma unroll
        for (int cc = 0; cc < 8; ++cc) { u32x4 pkd; pkd.x = pk2(vals[0][cc], vals[1][cc]); pkd.y = pk2(vals[2][cc], vals[3][cc]); pkd.z = pk2(vals[4][cc], vals[5][cc]); pkd.w = pk2(vals[6][cc], vals[7][cc]);
            *(LAS u32x4*)(lds + (lane * 8 + cc) * GM_VN_PITCH + chunk * 16) = pkd; }
    }
#pragma unroll
    for (int ks = 0; ks < 4; ++ks)
#pragma unroll
        for (int it = 0; it < 2; ++it) bfr[ks][it] = *(const bf16x8*)(wm + (ih * 64 + it * 32 + r) * 128 + 16 * ks + 8 * hh);
    __syncthreads();
    f32x16 acc[4][2];
#pragma unroll
    for (int ct = 0; ct < 4; ++ct)
#pragma unroll
        for (int it = 0; it < 2; ++it)
#pragma unroll
            for (int i = 0; i < 16; ++i) acc[ct][it][i] = 0.f;
#pragma unroll
    for (int ks = 0; ks < 8; ++ks) {
        if (ks + 4 < 8) {
#pragma unroll
            for (int it = 0; it < 2; ++it) bfr[ks + 4][it] = *(const bf16x8*)(wm + (ih * 64 + it * 32 + r) * 128 + 16 * (ks + 4) + 8 * hh); }
#pragma unroll
        for (int ct = 0; ct < 4; ++ct) { const int chunk = (2 * ks + hh) ^ ((ct * 4 + (r >> 3)) & 15);
            const bf16x8 a = *(const LAS bf16x8*)(lds + (g * 128 + ct * 32 + r) * GM_VN_PITCH + chunk * 16);
#pragma unroll
            for (int it = 0; it < 2; ++it) acc[ct][it] = mfma32(a, bfr[ks][it], acc[ct][it]); }
    }
    __builtin_amdgcn_sched_barrier(0);
    u32x4 ugv[16];
#pragma unroll
    for (int k = 0; k < 4; ++k) ugv[k] = *(const u32x4*)(P.zu + (row0 + k * 8 + wave) * 512 + lane * 8);
    __syncthreads();
#pragma unroll
    for (int it = 0; it < 2; ++it) { const int i = ih * 64 + it * 32 + r; const float bs = P.b_sp[g * 128 + i];
#pragma unroll
        for (int ct = 0; ct < 4; ++ct)
#pragma unroll
            for (int q = 0; q < 4; ++q) { const int c = g * 128 + ct * 32 + 8 * q + 4 * hh;
                u32x2 w; w.x = pk2(acc[ct][it][4 * q + 0] + bs, acc[ct][it][4 * q + 1] + bs); w.y = pk2(acc[ct][it][4 * q + 2] + bs, acc[ct][it][4 * q + 3] + bs);
                *(LAS u32x2*)(lds + i * GM_SP_PITCH + c * 2) = w; } }
    __syncthreads();
#pragma unroll
    for (int k = 4; k < 16; ++k) ugv[k] = *(const u32x4*)(P.zu + (row0 + k * 8 + wave) * 512 + lane * 8);
#pragma unroll
    for (int k = 0; k < 16; ++k) { const int i = k * 8 + wave; const size_t row = row0 + i;
        const u32x4 uu = ugv[k];
        const u32x4 sp = *(const LAS u32x4*)(lds + i * GM_SP_PITCH + lane * 16);
        u32x4 w;
        w.x = pk2(bflo(uu.x) * bflo(sp.x), bfhi(uu.x) * bfhi(sp.x));
        w.y = pk2(bflo(uu.y) * bflo(sp.y), bfhi(uu.y) * bfhi(sp.y));
        w.z = pk2(bflo(uu.z) * bflo(sp.z), bfhi(uu.z) * bfhi(sp.z));
        w.w = pk2(bflo(uu.w) * bflo(sp.w), bfhi(uu.w) * bfhi(sp.w));
        *(u32x4*)(P.mix + row * 1024 + lane * 8) = w; }
}

DI void gmlp_sample(int b, const Params& P, LAS unsigned char* lds) {
    int tid = threadIdx.x;
    asm volatile("" : "+v"(tid));
    const int wave = __builtin_amdgcn_readfirstlane(tid >> 6), lane = tid & 63;
    LAS float* vn = (LAS float*)lds;
    __syncthreads();
    for (int jj = 0; jj < 2; ++jj) { const int j = wave * 2 + jj; const size_t row = (size_t)MP + b * 16 + j;
        const u32x4 w = *(const u32x4*)(P.zv + row * 512 + lane * 8);
        const float xs[8] = {bflo(w.x), bfhi(w.x), bflo(w.y), bfhi(w.y), bflo(w.z), bfhi(w.z), bflo(w.w), bfhi(w.w)};
        float s1 = 0.f, s2 = 0.f;
#pragma unroll
        for (int cc = 0; cc < 8; ++cc) { s1 += xs[cc]; s2 += xs[cc] * xs[cc]; }
        s1 = wave_sum(s1); s2 = wave_sum(s2);
        const float mean = s1 * (1.f / 512.f), var = fmaxf(s2 * (1.f / 512.f) - mean * mean, 0.f), rstd = rsqrtf(var + EPS);
        float o[8];
#pragma unroll
        for (int cc = 0; cc < 8; ++cc) { o[cc] = (xs[cc] - mean) * rstd * P.ln_v_g[lane * 8 + cc] + P.ln_v_b[lane * 8 + cc]; vn[j * 512 + lane * 8 + cc] = o[cc]; }
        float* vo = P.v_sample + ((size_t)b * 16 + j) * 512 + lane * 8;
        *(f32x4*)(vo) = (f32x4){o[0], o[1], o[2], o[3]}; *(f32x4*)(vo + 4) = (f32x4){o[4], o[5], o[6], o[7]}; }
    __syncthreads();
    { const int c = tid, g = c >> 7;
      float vcol[16];
#pragma unroll
      for (int j = 0; j < 16; ++j) vcol[j] = vn[j * 512 + c];
      for (int i = 0; i < 16; ++i) { float s = P.b_sp[g * 128 + i];
#pragma unroll
          for (int j = 0; j < 16; ++j) s += P.w_sp[(g * 128 + i) * 128 + j] * vcol[j];
          const size_t row = (size_t)MP + b * 16 + i;
          const float o = bf1(P.zu[row * 512 + c]) * s;
          P.mix[row * 1024 + c] = (bf16_t)(pk2(o, 0.f) & 0xffffu); } }
}

constexpr int HG_QD = 0, HG_KI = 8704, HG_KE = 17408, HG_VT = 27648, HG_DEC = 37888, HG_OB = 38400, HG_SS = 55296, HG_STRIDE = 55808;
constexpr int HG_GN = 2 * HG_STRIDE;
DI bf16x8 pack8(const f32x16& x, int s) {
    u32x4 p; p.x = pk2(x[8 * s + 0], x[8 * s + 1]); p.y = pk2(x[8 * s + 2], x[8 * s + 3]); p.z = pk2(x[8 * s + 4], x[8 * s + 5]); p.w = pk2(x[8 * s + 6], x[8 * s + 7]);
    return __builtin_bit_cast(bf16x8, p);
}
DI f32x2 quad_bcast(f32x2 v, int j) {
    f32x2 r;
    if (j == 0) { r.x = dpp_f<0x00>(v.x); r.y = dpp_f<0x00>(v.y); }
    else if (j == 1) { r.x = dpp_f<0x55>(v.x); r.y = dpp_f<0x55>(v.y); }
    else if (j == 2) { r.x = dpp_f<0xAA>(v.x); r.y = dpp_f<0xAA>(v.y); }
    else { r.x = dpp_f<0xFF>(v.x); r.y = dpp_f<0xFF>(v.y); }
    return r;
}
struct HgCtx { size_t rowbase, hbase; int hc, wave, lane, r, hh, rsw, pq, pd0, pv2, ptq, ft, fv0; };
#define HG_BARRIER() do { asm volatile("s_waitcnt lgkmcnt(0)" ::: "memory"); __builtin_amdgcn_s_barrier(); asm volatile("" ::: "memory"); } while (0)
DI void hg_prep_iter(const int it, const HgCtx& C, const Params& P, LAS unsigned char* lds,
                unsigned (&Lfg)[8], unsigned (&Lq)[8], unsigned (&Lw)[8],
                const unsigned (&Ufg)[8], const unsigned (&Uq)[8], const unsigned (&Uw)[8]) {
    const int hc = C.hc;
    {
        { const int nb = (it + 2 < 64) ? it + 2 : 63;
          const size_t t0 = C.hbase + (size_t)nb * 32 * 128;
          const unsigned short* zfp = P.zf + t0 + C.pq * 8 * 128 + C.pd0;
          const bf16_t* zqp = P.zq + t0 + C.pq * 8 * 128 + C.pd0;
#pragma unroll
          for (int t = 0; t < 8; ++t) { Lfg[t] = *(const unsigned*)(zfp + t * 128); Lq[t] = *(const unsigned*)(zqp + t * 128); }
          const unsigned* zip = (const unsigned*)(P.zi + t0 + C.ptq * 8 * 128) + C.pv2;
#pragma unroll
          for (int i = 0; i < 8; ++i) Lw[i] = zip[i * 64]; }
        if (it < 64) {
            LAS unsigned char* B = lds + (it & 1) * HG_STRIDE;
            { f32x2 kv[8];
#pragma unroll
              for (int t = 0; t < 8; ++t) kv[t] = unpkh2(Ufg[t]);
              f32x2 pown = (f32x2){1.f, 1.f} - kv[0];
#pragma unroll
              for (int t = 1; t < 8; ++t) pown *= ((f32x2){1.f, 1.f} - kv[t]);
              const f32x2 p0 = quad_bcast(pown, 0), p1 = quad_bcast(pown, 1), p2 = quad_bcast(pown, 2), p3 = quad_bcast(pown, 3);
              const f32x2 c01 = p0 * p1, c012 = c01 * p2, dec = c012 * p3;
              f32x2 eb = (C.pq == 0) ? (f32x2){1.f, 1.f} : (C.pq == 1) ? p0 : (C.pq == 2) ? c01 : c012;
              f32x2 ie; ie.x = frcp(eb.x); ie.y = frcp(eb.y);
              float kex[8], key[8];
#pragma unroll
              for (int tt = 0; tt < 8; ++tt) {
                  const f32x2 k = kv[tt], fg = (f32x2){1.f, 1.f} - k;
                  f32x2 rf; rf.x = frcp(fg.x); rf.y = frcp(fg.y);
                  eb *= fg; ie *= rf;
                  const f32x2 qf = {bflo(Uq[tt]), bfhi(Uq[tt])};
                  const f32x2 qd = qf * eb, ki = k * ie, ke = ki * dec;
                  const int t = C.pq * 8 + tt;
                  const int off = t * 272 + ((C.pd0 * 2) ^ (C.pq << 5));
                  *(LAS unsigned*)(B + HG_QD + off) = pk2(qd.x, qd.y);
                  *(LAS unsigned*)(B + HG_KI + off) = pk2(ki.x, ki.y);
                  kex[tt] = ke.x; key[tt] = ke.y;
              }
              *(LAS u32x4*)(B + HG_KE + C.pd0 * 80 + C.pq * 16) = (u32x4){pk2(kex[0], kex[1]), pk2(kex[2], kex[3]), pk2(kex[4], kex[5]), pk2(kex[6], kex[7])};
              *(LAS u32x4*)(B + HG_KE + (C.pd0 + 1) * 80 + C.pq * 16) = (u32x4){pk2(key[0], key[1]), pk2(key[2], key[3]), pk2(key[4], key[5]), pk2(key[6], key[7])};
              if (C.pq == 0) *(LAS f32x2*)(B + HG_DEC + C.pd0 * 4) = dec; }
            { u32x4 lo, hi;
              lo.x = (Uw[0] & 0xffffu) | (Uw[1] << 16); lo.y = (Uw[2] & 0xffffu) | (Uw[3] << 16); lo.z = (Uw[4] & 0xffffu) | (Uw[5] << 16); lo.w = (Uw[6] & 0xffffu) | (Uw[7] << 16);
              hi.x = (Uw[0] >> 16) | (Uw[1] & 0xffff0000u); hi.y = (Uw[2] >> 16) | (Uw[3] & 0xffff0000u); hi.z = (Uw[4] >> 16) | (Uw[5] & 0xffff0000u); hi.w = (Uw[6] >> 16) | (Uw[7] & 0xffff0000u);
              *(LAS u32x4*)(B + HG_VT + (2 * C.pv2) * 80 + C.ptq * 16) = lo;
              *(LAS u32x4*)(B + HG_VT + (2 * C.pv2 + 1) * 80 + C.ptq * 16) = hi; }
        }
    }
    HG_BARRIER();
}
DI void hg_state_iter(const int it, const HgCtx& C, const Params& P, LAS unsigned char* lds, f32x16 (&S)[4],
                      u32x4& Lg0, u32x4& Lg1, const u32x4& Ug0, const u32x4& Ug1) {
    const int r = C.r, hh = C.hh, hc = C.hc;
    { const int gbk = (it >= 1) ? ((it - 1 < 64) ? it - 1 : 63) : 0;
      const bf16_t* gp = P.zgb + C.hbase + ((size_t)gbk * 32 + C.ft) * 128 + C.fv0;
      Lg0 = *(const u32x4*)(gp); Lg1 = *(const u32x4*)(gp + 8); }
    if (it >= 1 && it <= 64) {
        LAS unsigned char* B = lds + ((it - 1) & 1) * HG_STRIDE;
        const int sl = C.wave, rsw = C.rsw;
        bf16x8 fk[8], fq[8];
#pragma unroll
        for (int ks = 0; ks < 8; ++ks) { const int co = ((16 * ks + 8 * hh) * 2) ^ rsw;
            fk[ks] = *(const LAS bf16x8*)(B + HG_KI + r * 272 + co); fq[ks] = *(const LAS bf16x8*)(B + HG_QD + r * 272 + co); }
        s16x4 vlo[2], vhi[2], qlo[4][2], qhi[4][2];
#pragma unroll
        for (int st = 0; st < 2; ++st) { vlo[st] = *(const LAS s16x4*)(B + HG_VT + (sl * 32 + r) * 80 + 2 * (16 * st + 4 * hh)); vhi[st] = *(const LAS s16x4*)(B + HG_VT + (sl * 32 + r) * 80 + 2 * (16 * st + 4 * hh) + 16); }
#pragma unroll
        for (int dt = 0; dt < 4; ++dt)
#pragma unroll
            for (int st = 0; st < 2; ++st) { const int co = (2 * (32 * dt + 16 * st + 4 * hh)) ^ rsw;
                qlo[dt][st] = *(const LAS s16x4*)(B + HG_QD + r * 272 + co); qhi[dt][st] = *(const LAS s16x4*)(B + HG_QD + r * 272 + (co ^ 16)); }
        __builtin_amdgcn_sched_barrier(0);
        f32x16 at;
#pragma unroll
        for (int i = 0; i < 16; ++i) at[i] = 0.f;
#pragma unroll
        for (int ks = 0; ks < 8; ++ks) at = mfma32(fk[ks], fq[ks], at);
        __builtin_amdgcn_sched_barrier(0);
        bf16x8 fe[4][2], fv[2]; f32x4 dc[4][4];
#pragma unroll
        for (int st = 0; st < 2; ++st) fv[st] = *(const LAS bf16x8*)(B + HG_VT + (sl * 32 + r) * 80 + 2 * (16 * st + 8 * hh));
#pragma unroll
        for (int dt = 0; dt < 4; ++dt) {
#pragma unroll
            for (int st = 0; st < 2; ++st) fe[dt][st] = *(const LAS bf16x8*)(B + HG_KE + (32 * dt + r) * 80 + 2 * (16 * st + 8 * hh)); }
        __builtin_amdgcn_sched_barrier(0);
#pragma unroll
        for (int i = 0; i < 16; ++i) if (crow(i, hh) > r) at[i] = 0.f;
        f32x16 o;
#pragma unroll
        for (int i = 0; i < 16; ++i) o[i] = 0.f;
#pragma unroll
        for (int st = 0; st < 2; ++st) { const bf16x8 xs = pack8(at, st);
            const bf16x8 a = __builtin_shufflevector(vlo[st], vhi[st], 0, 1, 2, 3, 4, 5, 6, 7);
            o = mfma32(a, xs, o); }
#pragma unroll
        for (int dt = 0; dt < 4; ++dt)
#pragma unroll
            for (int st = 0; st < 2; ++st) { const bf16x8 xs = pack8(S[dt], st);
                const bf16x8 pb = __builtin_shufflevector(qlo[dt][st], qhi[dt][st], 0, 1, 2, 3, 4, 5, 6, 7);
                o = mfma32(xs, pb, o); }
        __builtin_amdgcn_sched_barrier(0);
#pragma unroll
        for (int dt = 0; dt < 4; ++dt)
#pragma unroll
            for (int q = 0; q < 4; ++q) dc[dt][q] = *(const LAS f32x4*)(B + HG_DEC + (32 * dt + 8 * q + 4 * hh) * 4);
#pragma unroll
        for (int dt = 0; dt < 4; ++dt) {
#pragma unroll
            for (int q = 0; q < 4; ++q)
#pragma unroll
                for (int j = 0; j < 4; ++j) S[dt][4 * q + j] *= dc[dt][q][j];
#pragma unroll
            for (int st = 0; st < 2; ++st) S[dt] = mfma32(fe[dt][st], fv[st], S[dt]);
        }
        float ssum = 0.f;
#pragma unroll
        for (int i = 0; i < 16; ++i) ssum += o[i] * o[i];
        ssum += __shfl_xor(ssum, 32, 64);
#pragma unroll
        for (int q = 0; q < 4; ++q) *(LAS f32x4*)(B + HG_OB + r * 528 + (sl * 32 + 8 * q + 4 * hh) * 4) = (f32x4){o[4 * q], o[4 * q + 1], o[4 * q + 2], o[4 * q + 3]};
        if (hh == 0) ((LAS float*)(B + HG_SS))[sl * 32 + r] = ssum;
    }
        if (it >= 2) {
            LAS unsigned char* B = lds + (it & 1) * HG_STRIDE;
            const int ft = C.ft, fv0 = C.fv0;
            const size_t row = C.rowbase + (size_t)(it - 2) * 32 + ft;
            LAS float* SSp = (LAS float*)(B + HG_SS);
            const float ss = SSp[ft] + SSp[32 + ft] + SSp[64 + ft] + SSp[96 + ft];
            const float rstd = rsqrtf(ss * (1.f / 128.f) + EPS);
            const float sg[16] = {bflo(Ug0.x), bfhi(Ug0.x), bflo(Ug0.y), bfhi(Ug0.y), bflo(Ug0.z), bfhi(Ug0.z), bflo(Ug0.w), bfhi(Ug0.w),
                                  bflo(Ug1.x), bfhi(Ug1.x), bflo(Ug1.y), bfhi(Ug1.y), bflo(Ug1.z), bfhi(Ug1.z), bflo(Ug1.w), bfhi(Ug1.w)};
            float o[16];
#pragma unroll
            for (int q4 = 0; q4 < 4; ++q4) { const f32x4 ov = *(const LAS f32x4*)(B + HG_OB + ft * 528 + (fv0 + q4 * 4) * 4); const f32x4 gn = *(const LAS f32x4*)(lds + HG_GN + (fv0 + q4 * 4) * 4);
#pragma unroll
                for (int j = 0; j < 4; ++j) o[q4 * 4 + j] = ov[j] * rstd * gn[j] * sg[q4 * 4 + j]; }
            u32x4 w0, w1; w0.x = pk2(o[0], o[1]); w0.y = pk2(o[2], o[3]); w0.z = pk2(o[4], o[5]); w0.w = pk2(o[6], o[7]);
            w1.x = pk2(o[8], o[9]); w1.y = pk2(o[10], o[11]); w1.z = pk2(o[12], o[13]); w1.w = pk2(o[14], o[15]);
            bf16_t* mp = P.mix + row * 1024 + 512 + hc + fv0;
            *(u32x4*)(mp) = w0; *(u32x4*)(mp + 8) = w1;
        }
    HG_BARRIER();
}
DI void hgrn_chain(int b, int h, const Params& P, LAS unsigned char* lds) {
    const int tid = threadIdx.x;
    HgCtx C;
    C.wave = __builtin_amdgcn_readfirstlane(tid >> 6); C.lane = tid & 63; C.r = C.lane & 31; C.hh = C.lane >> 5;
    C.rowbase = (size_t)b * SEQ; C.hbase = (size_t)(b * 4 + h) * 2048 * 128; C.hc = h * 128; C.rsw = ((C.r >> 3) & 3) << 5;
    const int ptid = tid & 255;
    C.pq = C.lane & 3; C.pd0 = (((ptid >> 6) * 16) + (C.lane >> 2)) * 2;
    C.pv2 = ptid & 63; C.ptq = ptid >> 6; C.ft = ptid >> 3; C.fv0 = (ptid & 7) * 16;
    __syncthreads();
    if (tid < 128) ((LAS float*)(lds + HG_GN))[tid] = P.gnorm_g[C.hc + tid];
    if (C.wave >= 4) {
        unsigned fgA[8], fgB[8], fgC[8]; unsigned qA[8], qB[8], qC[8], wA[8], wB[8], wC[8];
#pragma unroll
        for (int t = 0; t < 8; ++t) { fgA[t] = 0u; qA[t] = 0u; wA[t] = 0u; }
#pragma unroll
        for (int pb = 0; pb < 2; ++pb) {
            const size_t t0 = C.hbase + (size_t)pb * 32 * 128;
            const unsigned short* zfp = P.zf + t0 + C.pq * 8 * 128 + C.pd0;
            const bf16_t* zqp = P.zq + t0 + C.pq * 8 * 128 + C.pd0;
            const unsigned* zip = (const unsigned*)(P.zi + t0 + C.ptq * 8 * 128) + C.pv2;
#pragma unroll
            for (int t = 0; t < 8; ++t) {
                if (pb == 0) { fgB[t] = *(const unsigned*)(zfp + t * 128); qB[t] = *(const unsigned*)(zqp + t * 128); wB[t] = zip[t * 64]; }
                else { fgC[t] = *(const unsigned*)(zfp + t * 128); qC[t] = *(const unsigned*)(zqp + t * 128); wC[t] = zip[t * 64]; } }
        }
#pragma unroll 1
        for (int it = 0; it < 66; it += 3) {
            hg_prep_iter(it,     C, P, lds, fgA, qA, wA, fgB, qB, wB);
            hg_prep_iter(it + 1, C, P, lds, fgB, qB, wB, fgC, qC, wC);
            hg_prep_iter(it + 2, C, P, lds, fgC, qC, wC, fgA, qA, wA);
        }
    } else {
        f32x16 S[4];
#pragma unroll
        for (int dt = 0; dt < 4; ++dt)
#pragma unroll
            for (int i = 0; i < 16; ++i) S[dt][i] = 0.f;
        u32x4 gX0 = {0u, 0u, 0u, 0u}, gX1 = gX0, gY0 = gX0, gY1 = gX0;
#pragma unroll 1
        for (int it = 0; it < 66; it += 2) {
            hg_state_iter(it,     C, P, lds, S, gX0, gX1, gY0, gY1);
            hg_state_iter(it + 1, C, P, lds, S, gY0, gY1, gX0, gX1);
        }
        float* so = P.st_prompt + ((size_t)(b * 4 + h) * 128) * 128 + C.wave * 32 + C.r;
#pragma unroll
        for (int dt = 0; dt < 4; ++dt)
#pragma unroll
            for (int i = 0; i < 16; ++i) so[(size_t)(32 * dt + crow(i, C.hh)) * 128] = S[dt][i];
    }
}

DI void hgrn_sample(int b, int h, const Params& P, LAS unsigned char* lds) {
    int tid = threadIdx.x;
    asm volatile("" : "+v"(tid));
    LAS float* Q = (LAS float*)lds; LAS float* F = Q + 2048; LAS float* K = F + 2048; LAS float* VV = K + 2048; LAS float* OP = VV + 2048;
    const int hc = h * 128;
    __syncthreads();
    for (int e = tid; e < 2048; e += NTHREADS) { const int t = e >> 7, d = e & 127; const size_t row = (size_t)MP + b * 16 + t;
        const size_t ho = hoff((int)row, h) + d;
        const float f = 1.f - (float)__builtin_bit_cast(_Float16, P.zf[ho]);
        Q[e] = bf1(P.zq[ho]); F[e] = f; K[e] = 1.f - f; VV[e] = bf1(P.zi[ho]); }
    __syncthreads();
    { const int v = tid & 127, dq = tid >> 7;
      float S[32];
      const float* sin_ = P.state_in + ((size_t)(b * 4 + h) * 128 + dq * 32) * 128 + v;
#pragma unroll
      for (int dd = 0; dd < 32; ++dd) S[dd] = sin_[(size_t)dd * 128];
      for (int t = 0; t < 16; ++t) { const float vvv = VV[t * 128 + v]; float op = 0.f;
#pragma unroll
          for (int dd = 0; dd < 32; ++dd) { const int d = dq * 32 + dd; S[dd] = F[t * 128 + d] * S[dd] + K[t * 128 + d] * vvv; op += S[dd] * Q[t * 128 + d]; }
          OP[(t * 4 + dq) * 128 + v] = op; }
      float* so = P.st_sample + ((size_t)(b * 4 + h) * 128 + dq * 32) * 128 + v;
#pragma unroll
      for (int dd = 0; dd < 32; ++dd) so[(size_t)dd * 128] = S[dd]; }
    __syncthreads();
    { const int t = tid >> 5, v = (tid & 31) * 4; const size_t row = (size_t)MP + b * 16 + t;
      float o[4]; float ss = 0.f;
#pragma unroll
      for (int j = 0; j < 4; ++j) { o[j] = OP[(t * 4 + 0) * 128 + v + j] + OP[(t * 4 + 1) * 128 + v + j] + OP[(t * 4 + 2) * 128 + v + j] + OP[(t * 4 + 3) * 128 + v + j]; ss += o[j] * o[j]; }
#pragma unroll
      for (int m = 16; m >= 1; m >>= 1) ss += __shfl_xor(ss, m, 64);
      const float rstd = rsqrtf(ss * (1.f / 128.f) + EPS);
      const u32x2 gb = *(const u32x2*)(P.zgb + hoff((int)row, h) + v);
      const float sg[4] = {bflo(gb.x), bfhi(gb.x), bflo(gb.y), bfhi(gb.y)};
#pragma unroll
      for (int j = 0; j < 4; ++j) o[j] = o[j] * rstd * P.gnorm_g[hc + v + j] * sg[j];
      u32x2 w; w.x = pk2(o[0], o[1]); w.y = pk2(o[2], o[3]);
      *(u32x2*)(P.mix + row * 1024 + 512 + hc + v) = w; }
}

__global__ void __launch_bounds__(NTHREADS, 2) fwd_mega(Params P) {
    extern __shared__ __attribute__((aligned(16))) unsigned char lds_raw[];
    LAS unsigned char* lds = (LAS unsigned char*)lds_raw;
    cg::grid_group grid = cg::this_grid();
    const int G = gridDim.x, bid = blockIdx.x;
    const int lo = P.ph_lo, hi = P.ph_hi;
    if (hi < 0) grid.sync();
    volatile LAS unsigned* bst = (volatile LAS unsigned*)(lds + 140 * 1024 + 64);
    if (threadIdx.x < 2) bst[threadIdx.x] = 0u;
    __syncthreads();
    const XcdBarrier xbar = xcd_barrier_post(P.bar, bst);
#define IN(k) (lo <= (k) && (k) < hi)
#define SEAM(k) do { if (IN(k) && IN((k) + 1)) xcd_barrier(xbar); } while (0)

    if (IN(0)) phase0(P, lds);
    SEAM(0);

    if (IN(1)) {
        for (int w = bid; w < 256; w += G)
            p1_rows(P.x_prompt + (size_t)w * 256 * 1024, P.hb + (size_t)w * 256 * 1024, 256, 16, P.mod + (w >> 3) * 5120, P.norm_g, (LAS float*)lds);
        for (int w = bid; w < 16; w += G)
            p1_rows(P.x_sample + (size_t)w * 16 * 1024, P.hb + ((size_t)MP + w * 16) * 1024, 16, 16, P.mod + (32 + w) * 5120, P.norm_g, (LAS float*)lds);
    }
    SEAM(1);

    if (IN(2)) {
        { const int dly = ((bid >> 3) & 7) * 16 + (bid & 7) * 2;
          for (int i = 0; i < dly; ++i) __builtin_amdgcn_s_sleep(8); }
        pg8::Gemm g{P.hb, P.winT, MT, INW, DM}; pg8::StaticOrder S; S.init(MT, INW, G, bid);
        EpiZ E{P.zu, P.zf, P.lb_logits};
        pg8::gemm_phase<EpiZ, pg8::StaticOrder>(lds, g, S, E);
    }
    SEAM(2);

    if (IN(3)) {
        if (bid < 128) hgrn_chain(bid >> 2, bid & 3, P, lds);
        LAS unsigned* qw = (LAS unsigned*)(lds + 140 * 1024);
        for (;;) {
            __syncthreads();
            if (threadIdx.x == 0) *qw = atomicAdd(P.ctr, 1u);
            __syncthreads();
            const int i = (int)*qw;
            if (i >= 512 + 16 + 64) break;
            if (i < 512) gmlp_item(i >> 4, i & 15, P, lds);
            else if (i < 528) gmlp_sample(i - 512, P, lds);
            else { const int q = i - 528; hgrn_sample(q >> 2, q & 3, P, lds); }
        }
    }
    SEAM(3);

    if (IN(4)) {
        for (int i = bid; i < 4 * 64; i += G) sgemm_out_item(P.mix + (size_t)MP * 1024, P.woutT, i & 3, i >> 2, P.xnew, lds);
        __syncthreads();
        pg8::Gemm g{P.mix, P.woutT, MP, DM, DM}; pg8::StaticOrder S; S.init(MP, DM, G, bid);
        EpiOut E{P.xnew};
        pg8::gemm_phase<EpiOut, pg8::StaticOrder>(lds, g, S, E);
    }
    SEAM(4);

    if (IN(5)) {
        for (int w = bid; w < 256; w += G)
            p5_rows(P.x_prompt + (size_t)w * 256 * 1024, P.xnew + (size_t)w * 256 * 1024, P.y_prompt + (size_t)w * 256 * 1024, 256, 16, P.mod + (w >> 3) * 5120, P.g_final, (LAS float*)lds);
        for (int w = bid; w < 16; w += G)
            p5_rows(P.x_sample + (size_t)w * 16 * 1024, P.xnew + ((size_t)MP + w * 16) * 1024, P.y_sample + (size_t)w * 16 * 1024, 16, 16, P.mod + (32 + w) * 5120, P.g_final, (LAS float*)lds);
    }
#undef IN
#undef SEAM
}

#ifndef MK_N_LAUNCHES
#define MK_N_LAUNCHES 1
#endif

extern "C" void kernel_launch(void* const* d_in, const int* in_sizes, int n_in, void* d_out, int out_size, void* d_ws, size_t ws_size, hipStream_t stream) {
    static int grid_blocks = 0;
    if (!grid_blocks) {
        int dev = 0, cus = 0, per_cu = 0;
        hipGetDevice(&dev);
        hipDeviceGetAttribute(&cus, hipDeviceAttributeMultiprocessorCount, dev);
        hipFuncSetAttribute((const void*)fwd_mega, hipFuncAttributeMaxDynamicSharedMemorySize, LDS_BYTES);
        hipOccupancyMaxActiveBlocksPerMultiprocessor(&per_cu, (const void*)fwd_mega, NTHREADS, LDS_BYTES);
        if (per_cu < 1) { fprintf(stderr, "kernel_launch: occupancy query returned %d\n", per_cu); per_cu = 1; }
        (void)hipGetLastError();
        grid_blocks = cus * 1;
        if (ws_size < WS_END) fprintf(stderr, "kernel_launch: workspace too small: %zu < %zu\n", ws_size, (size_t)WS_END);
    }
    Params p{};
    const float* const* in = (const float* const*)d_in;
    p.x_prompt = in[0]; p.x_sample = in[1]; p.c_prompt = in[2]; p.c_sample = in[3]; p.state_in = in[4];
    p.norm_g = in[5]; p.w_ada = in[6]; p.b_ada = in[7]; p.w_in = in[8]; p.ln_v_g = in[9]; p.ln_v_b = in[10];
    p.w_sp = in[11]; p.b_sp = in[12]; p.lb_logits = in[13]; p.gnorm_g = in[14]; p.w_out = in[15]; p.g_final = in[16];
    p.w_ada_f = in[17]; p.b_ada_f = in[18];
    float* out = (float*)d_out;
    p.y_prompt = out; p.y_sample = out + (size_t)MP * 1024; p.st_prompt = p.y_sample + (size_t)MS * 1024;
    p.st_sample = p.st_prompt + (size_t)32 * 4 * 128 * 128; p.v_sample = p.st_sample + (size_t)16 * 4 * 128 * 128;
    unsigned char* ws = (unsigned char*)d_ws;
    p.hb = (bf16_t*)(ws + WS_HB); p.winT = (bf16_t*)(ws + WS_WINT); p.woutT = (bf16_t*)(ws + WS_WOUTT); p.mod = (float*)(ws + WS_MODZ);
    p.rowss = (float*)(ws + WS_ROWSS); p.wm = (bf16_t*)(ws + WS_WM);
    bf16_t* zb = (bf16_t*)(ws + WS_ZB); const size_t zs = (size_t)MT * 512;
    p.zu = zb; p.zv = zb + zs; p.zga = zb + 2 * zs; p.zq = zb + 3 * zs; p.zi = zb + 4 * zs; p.zgb = zb + 5 * zs; p.zf = (unsigned short*)(ws + WS_ZF);
    p.mix = (bf16_t*)(ws + WS_MIX); p.xnew = (bf16_t*)(ws + WS_XNEW); p.ctr = (unsigned*)(ws + WS_CTR); p.bar = (unsigned*)(ws + WS_BAR);
    (void)hipMemsetAsync(ws + WS_BAR, 0, WS_BAR_BYTES, stream);
#if MK_N_LAUNCHES == 1
    p.ph_lo = 0; p.ph_hi = 6;
    void* args[] = {&p};
    hipError_t e = hipLaunchCooperativeKernel((const void*)fwd_mega, dim3(grid_blocks), dim3(NTHREADS), args, LDS_BYTES, stream);
    if (e != hipSuccess) fprintf(stderr, "cooperative launch failed: %s (grid %d)\n", hipGetErrorString(e), grid_blocks);
#else
    for (int ph = 0; ph < 6; ++ph) { p.ph_lo = ph; p.ph_hi = ph + 1;
        hipLaunchKernelGGL(fwd_mega, dim3(grid_blocks), dim3(NTHREADS), LDS_BYTES, stream, p); }
#endif
}
```
